# Optimizing an MI355X kernel written in HIP

```python
import math
import jax, jax.numpy as jnp
from jax import lax
import numpy as np

D_MODEL = 1024
BATCH = 2
SEQ = 8192
DEPTH = 1

D_MIX = 2 * D_MODEL
D_SSM = D_MIX // 2
SSM_HEAD_DIM = 64
SSM_HEADS = D_SSM // SSM_HEAD_DIM
SSM_GROUPS = 2
SSM_HEADS_PER_GROUP = SSM_HEADS // SSM_GROUPS
D_STATE = 128
D_CONV = 5
CHUNK = 128
D_XBC = D_SSM + 2 * SSM_GROUPS * D_STATE
D_ATTN = D_MIX - D_SSM
ATTN_HEADS = 8
ATTN_HEAD_DIM = D_ATTN // ATTN_HEADS // 2
ATTN_V_DIM = 2 * ATTN_HEAD_DIM
Q_BLOCK = 128
D_IN_PROJ = D_SSM + D_XBC + 2 * SSM_HEADS + 4 * D_ATTN
ALPHA = (2.0 * DEPTH) ** 0.25
BETA = (8.0 * DEPTH) ** -0.25
LN_EPS = 1e-5
RMS_EPS = 1e-5

kernel_name = "hybrid_ssd_diffattn_deepnorm_encoder"


def layer_norm(x, g, b):
    xf = x.astype(jnp.float32)
    mu = jnp.mean(xf, axis=-1, keepdims=True)
    var = jnp.mean(jnp.square(xf - mu), axis=-1, keepdims=True)
    return ((xf - mu) * lax.rsqrt(var + LN_EPS) * g + b).astype(x.dtype)


def rms_norm(x, g):
    xf = x.astype(jnp.float32)
    ms = jnp.mean(jnp.square(xf), axis=-1, keepdims=True)
    return (xf * lax.rsqrt(ms + RMS_EPS) * g).astype(x.dtype)


def centred_dwconv(u, w, b):
    out = lax.conv_general_dilated(
        u, w[:, None, :].astype(u.dtype), window_strides=(1,),
        padding=[(D_CONV // 2, D_CONV // 2)],
        dimension_numbers=("NWC", "WIO", "NWC"),
        feature_group_count=u.shape[-1])
    return out + b.astype(u.dtype)


def ssd_chunked(x, dt, A, Bm, Cm):
    b, s, g, j, p = x.shape
    n = Bm.shape[-1]
    nc = s // CHUNK
    x = x.reshape(b, nc, CHUNK, g, j, p)
    dt = dt.reshape(b, nc, CHUNK, g, j)
    Bm = Bm.reshape(b, nc, CHUNK, g, n)
    Cm = Cm.reshape(b, nc, CHUNK, g, n)
    a_cs = jnp.cumsum(dt * A, axis=2)
    xdt = x * dt[..., None]
    lower = jnp.tril(jnp.ones((CHUNK, CHUNK), dtype=bool))[None, None, :, :, None, None]
    seg = a_cs[:, :, :, None] - a_cs[:, :, None, :]
    decay = jnp.exp(jnp.where(lower, seg, -jnp.inf))
    cb = jnp.einsum("bclgn,bcsgn->bclsg", Cm, Bm)
    y_diag = jnp.einsum("bclsgj,bcsgjp->bclgjp", cb[..., None] * decay, xdt)
    decay_to_end = jnp.exp(a_cs[:, :, -1:] - a_cs)
    chunk_states = jnp.einsum("bclgn,bclgjp->bcgjpn", Bm, xdt * decay_to_end[..., None])
    chunk_decay = jnp.exp(a_cs[:, :, -1])

    def step(h, inp):
        st, dec = inp
        return dec[..., None, None] * h + st, h

    h0 = jnp.zeros((b, g, j, p, n), x.dtype)
    _, prev = lax.scan(step, h0, (jnp.moveaxis(chunk_states, 1, 0),
                                  jnp.moveaxis(chunk_decay, 1, 0)))
    prev = jnp.moveaxis(prev, 0, 1)
    y_off = jnp.einsum("bclgn,bcgjpn->bclgjp", Cm, prev) * jnp.exp(a_cs)[..., None]
    return (y_diag + y_off).reshape(b, s, g, j, p)


def bidirectional_ssd(xs, dt_f, dt_b, Bm, Cm, A_log_f, A_log_b, dt_bias_f, dt_bias_b, D):
    b, s = xs.shape[:2]
    shp = (SSM_GROUPS, SSM_HEADS_PER_GROUP)
    A_f = -jnp.exp(A_log_f.astype(jnp.float32)).reshape(shp)
    A_b = -jnp.exp(A_log_b.astype(jnp.float32)).reshape(shp)
    dtf = jax.nn.softplus(dt_f.astype(jnp.float32) + dt_bias_f.astype(jnp.float32)).reshape(b, s, *shp)
    dtb = jax.nn.softplus(dt_b.astype(jnp.float32) + dt_bias_b.astype(jnp.float32)).reshape(b, s, *shp)
    xf, Bf, Cf = xs.astype(jnp.float32), Bm.astype(jnp.float32), Cm.astype(jnp.float32)
    flip = lambda t: jnp.flip(t, axis=1)
    y_fwd = ssd_chunked(xf, dtf, A_f, Bf, Cf)
    y_bwd = flip(ssd_chunked(flip(xf), flip(dtb), A_b, flip(Bf), flip(Cf)))
    y = y_fwd + y_bwd + D.astype(jnp.float32).reshape(*shp, 1) * xf
    return y.astype(xs.dtype)


def diff_attention(q, k, v, lam, slopes):
    b, s, h, _, d = q.shape
    nb = s // Q_BLOCK
    scale = ATTN_HEAD_DIM ** -0.5
    k_pos = jnp.arange(s)
    qb = jnp.moveaxis(q.reshape(b, nb, Q_BLOCK, h, 2, d), 1, 0)
    starts = jnp.arange(nb) * Q_BLOCK

    def block(args):
        qi, start = args
        scores = jnp.einsum("bqhrd,bshrd->bhrqs", qi, k).astype(jnp.float32) * scale
        dist = jnp.abs((start + jnp.arange(Q_BLOCK))[:, None] - k_pos[None, :]).astype(jnp.float32)
        scores = scores - slopes[None, :, None, None, None] * dist[None, None, None]
        probs = jax.nn.softmax(scores, axis=-1)
        w = probs[:, :, 0] - lam * probs[:, :, 1]
        return jnp.einsum("bhqs,bshe->bqhe", w.astype(v.dtype), v)

    o = lax.map(block, (qb, starts))
    return jnp.moveaxis(o, 0, 1).reshape(b, s, h, v.shape[-1])


def hybrid_layer(h, layer_idx, w_in, conv_w, conv_b, A_log_f, A_log_b, dt_bias_f, dt_bias_b,
                 D, ssm_norm_g, lq1, lk1, lq2, lk2, subln_g, w_out, ln_g, ln_b):
    b, s, _ = h.shape
    proj = jnp.einsum("bsd,de->bse", h, w_in.astype(h.dtype))
    offs = np.cumsum([D_SSM, D_XBC, SSM_HEADS, SSM_HEADS, D_ATTN, D_ATTN, D_ATTN, D_ATTN])[:-1].tolist()
    z, xbc, dt_f, dt_b, q, k, v, g = jnp.split(proj, offs, axis=-1)

    xbc = jax.nn.silu(centred_dwconv(xbc, conv_w, conv_b))
    xs, Bm, Cm = jnp.split(xbc, [D_SSM, D_SSM + SSM_GROUPS * D_STATE], axis=-1)
    xs = xs.reshape(b, s, SSM_GROUPS, SSM_HEADS_PER_GROUP, SSM_HEAD_DIM)
    Bm = Bm.reshape(b, s, SSM_GROUPS, D_STATE)
    Cm = Cm.reshape(b, s, SSM_GROUPS, D_STATE)
    y = bidirectional_ssd(xs, dt_f, dt_b, Bm, Cm, A_log_f, A_log_b, dt_bias_f, dt_bias_b, D)
    y = y.reshape(b, s, SSM_GROUPS, D_SSM // SSM_GROUPS)
    zg = jax.nn.silu(z).reshape(b, s, SSM_GROUPS, D_SSM // SSM_GROUPS)
    y_ssm = rms_norm(y * zg, ssm_norm_g.reshape(SSM_GROUPS, -1)).reshape(b, s, D_SSM)

    q = q.reshape(b, s, ATTN_HEADS, 2, ATTN_HEAD_DIM)
    k = k.reshape(b, s, ATTN_HEADS, 2, ATTN_HEAD_DIM)
    v = v.reshape(b, s, ATTN_HEADS, ATTN_V_DIM)
    lam_init = 0.8 - 0.6 * math.exp(-0.3 * layer_idx)
    lam = (jnp.exp(jnp.sum(lq1.astype(jnp.float32) * lk1.astype(jnp.float32)))
           - jnp.exp(jnp.sum(lq2.astype(jnp.float32) * lk2.astype(jnp.float32))) + lam_init)
    slopes = jnp.exp2(-8.0 * (jnp.arange(ATTN_HEADS, dtype=jnp.float32) + 1.0) / ATTN_HEADS)
    o = diff_attention(q, k, v, lam, slopes)
    o = rms_norm(o, subln_g) * (1.0 - lam_init)
    y_attn = o.reshape(b, s, D_ATTN) * jax.nn.silu(g)

    mix = jnp.einsum("bse,ed->bsd", jnp.concatenate([y_ssm, y_attn], axis=-1), w_out.astype(h.dtype))
    return layer_norm(ALPHA * h + mix, ln_g, ln_b)


def setup_inputs(seed: int = 0) -> dict:
    key = jax.random.key(seed)
    ks = jax.random.split(key, 24)
    f32 = jnp.float32
    x = jax.random.normal(ks[0], (BATCH, SEQ, D_MODEL), f32)
    ln_emb_g = 1.0 + 0.02 * jax.random.normal(ks[1], (D_MODEL,), f32)
    ln_emb_b = 0.02 * jax.random.normal(ks[2], (D_MODEL,), f32)
    x_start = D_SSM
    v_start = D_SSM + D_XBC + 2 * SSM_HEADS + 2 * D_ATTN
    col_scale = (jnp.ones((D_IN_PROJ,), f32)
                 .at[x_start:x_start + D_SSM].set(BETA)
                 .at[v_start:v_start + D_ATTN].set(BETA))
    w_in = jax.random.normal(ks[3], (DEPTH, D_MODEL, D_IN_PROJ), f32) * (D_MODEL ** -0.5) * col_scale
    conv_w = jax.random.normal(ks[4], (DEPTH, D_CONV, D_XBC), f32) * (D_CONV ** -0.5)
    conv_b = 0.01 * jax.random.normal(ks[5], (DEPTH, D_XBC), f32)
    A_log_fwd = jnp.log(jax.random.uniform(ks[6], (DEPTH, SSM_HEADS), f32, 1.0, 16.0))
    A_log_bwd = jnp.log(jax.random.uniform(ks[7], (DEPTH, SSM_HEADS), f32, 1.0, 16.0))
    dt_f0 = jnp.exp(jax.random.uniform(ks[8], (DEPTH, SSM_HEADS), f32, math.log(1e-3), math.log(1e-1)))
    dt_b0 = jnp.exp(jax.random.uniform(ks[9], (DEPTH, SSM_HEADS), f32, math.log(1e-3), math.log(1e-1)))
    dt_bias_fwd = dt_f0 + jnp.log(-jnp.expm1(-dt_f0))
    dt_bias_bwd = dt_b0 + jnp.log(-jnp.expm1(-dt_b0))
    D_skip = 1.0 + 0.1 * jax.random.normal(ks[10], (DEPTH, SSM_HEADS), f32)
    ssm_norm_g = 1.0 + 0.02 * jax.random.normal(ks[11], (DEPTH, D_SSM), f32)
    lambda_q1 = 0.1 * jax.random.normal(ks[12], (DEPTH, ATTN_HEAD_DIM), f32)
    lambda_k1 = 0.1 * jax.random.normal(ks[13], (DEPTH, ATTN_HEAD_DIM), f32)
    lambda_q2 = 0.1 * jax.random.normal(ks[14], (DEPTH, ATTN_HEAD_DIM), f32)
    lambda_k2 = 0.1 * jax.random.normal(ks[15], (DEPTH, ATTN_HEAD_DIM), f32)
    subln_g = 1.0 + 0.02 * jax.random.normal(ks[16], (DEPTH, ATTN_V_DIM), f32)
    w_out = jax.random.normal(ks[17], (DEPTH, D_MIX, D_MODEL), f32) * (D_MIX ** -0.5) * BETA
    ln_g = 1.0 + 0.02 * jax.random.normal(ks[18], (DEPTH, D_MODEL), f32)
    ln_b = 0.02 * jax.random.normal(ks[19], (DEPTH, D_MODEL), f32)
    return {"x": x, "ln_emb_g": ln_emb_g, "ln_emb_b": ln_emb_b, "w_in": w_in,
            "conv_w": conv_w, "conv_b": conv_b, "A_log_fwd": A_log_fwd, "A_log_bwd": A_log_bwd,
            "dt_bias_fwd": dt_bias_fwd, "dt_bias_bwd": dt_bias_bwd, "D_skip": D_skip,
            "ssm_norm_g": ssm_norm_g, "lambda_q1": lambda_q1, "lambda_k1": lambda_k1,
            "lambda_q2": lambda_q2, "lambda_k2": lambda_k2, "subln_g": subln_g,
            "w_out": w_out, "ln_g": ln_g, "ln_b": ln_b}


def reference(x, ln_emb_g, ln_emb_b, w_in, conv_w, conv_b, A_log_fwd, A_log_bwd,
              dt_bias_fwd, dt_bias_bwd, D_skip, ssm_norm_g, lambda_q1, lambda_k1,
              lambda_q2, lambda_k2, subln_g, w_out, ln_g, ln_b):
    h = layer_norm(x, ln_emb_g, ln_emb_b)
    for l in range(DEPTH):
        h = hybrid_layer(h, l, w_in[l], conv_w[l], conv_b[l], A_log_fwd[l], A_log_bwd[l],
                         dt_bias_fwd[l], dt_bias_bwd[l], D_skip[l], ssm_norm_g[l],
                         lambda_q1[l], lambda_k1[l], lambda_q2[l], lambda_k2[l],
                         subln_g[l], w_out[l], ln_g[l], ln_b[l])
    return h
```

```cpp
#include <hip/hip_runtime.h>
#include <hip/hip_cooperative_groups.h>
#include <cstdio>
#include <cstdint>
namespace cg = cooperative_groups;

#define DI __device__ __forceinline__
typedef unsigned short u16;
typedef short bf16x8 __attribute__((ext_vector_type(8)));
typedef short bf16x4 __attribute__((ext_vector_type(4)));
typedef float f32x16 __attribute__((ext_vector_type(16)));
typedef float f32x4 __attribute__((ext_vector_type(4)));
typedef float f32x2 __attribute__((ext_vector_type(2)));
typedef __bf16 bf2_t __attribute__((ext_vector_type(2)));
typedef unsigned u32x4 __attribute__((ext_vector_type(4)));
typedef unsigned u32x2 __attribute__((ext_vector_type(2)));
#define MFMA(a, b, c) __builtin_amdgcn_mfma_f32_32x32x16_bf16((a), (b), (c), 0, 0, 0)

constexpr int M_TOK = 16384;
constexpr float LOG2E = 1.4426950408889634f;
constexpr float ALPHA_DN = 1.189207115002721f;

constexpr size_t SZ_ACT = (size_t)M_TOK * 1024 * 2;
constexpr size_t OFF_Z = 0;
constexpr size_t OFF_XBC = OFF_Z + SZ_ACT;
constexpr size_t OFF_Q = OFF_XBC + (size_t)M_TOK * 1536 * 2;
constexpr size_t OFF_K = OFF_Q + SZ_ACT;
constexpr size_t OFF_VT = OFF_K + SZ_ACT;
constexpr size_t OFF_G = OFF_VT + SZ_ACT;
constexpr size_t OFF_YL = OFF_G + SZ_ACT;
constexpr size_t OFF_DT = OFF_YL + SZ_ACT;
constexpr size_t OFF_EA = OFF_DT + (size_t)M_TOK * 32 * 4;
constexpr size_t OFF_WOT = OFF_EA + (size_t)M_TOK * 32 * 4;
constexpr size_t OFF_STATS = OFF_WOT + (size_t)1024 * 2048 * 2;
constexpr size_t OFF_DEC = OFF_STATS + (size_t)M_TOK * 2 * 4;
constexpr size_t OFF_KN = OFF_DEC + (size_t)2 * 16 * 2 * 64 * 4;
constexpr size_t OFF_CTR = OFF_KN + 256;
constexpr size_t OFF_BAR = OFF_CTR + 256;
constexpr size_t WS_NEED = OFF_BAR + 16384;
constexpr int LDS_BYTES = 153616;

struct Params {
    const float *x, *ln_emb_g, *ln_emb_b, *w_in, *conv_w, *conv_b, *A_log_f, *A_log_b, *dt_bias_f, *dt_bias_b, *D,
        *ssm_norm_g, *lq1, *lk1, *lq2, *lk2, *subln_g, *w_out, *ln_g, *ln_b;
    float* out;
    char* ws;
};

DI unsigned pk2(float lo, float hi) { f32x2 v = {lo, hi}; bf2_t b = __builtin_convertvector(v, bf2_t); return __builtin_bit_cast(unsigned, b); }
DI u16 tobf(float x) { return (u16)(pk2(x, 0.f) & 0xffffu); }
DI float bf2f(u16 v) { return __uint_as_float(((unsigned)v) << 16); }
DI float bflo(unsigned u) { return __uint_as_float(u << 16); }
DI float bfhi(unsigned u) { return __uint_as_float(u & 0xffff0000u); }
DI float wsum(float v) {
#pragma unroll
    for (int o = 32; o > 0; o >>= 1) v += __shfl_xor(v, o);
    return v;
}
DI float siluf(float v) { return v / (1.f + __expf(-v)); }
DI float softplusf(float x) { return x > 20.f ? x : log1pf(expf(x)); }
DI int otid(int wv) { int t = wv * 64 + (int)__builtin_amdgcn_mbcnt_hi(~0u, __builtin_amdgcn_mbcnt_lo(~0u, 0u)); asm volatile("" : "+v"(t)); return t; }
DI int crow(int i, int hh) { return (i & 3) + 8 * (i >> 2) + 4 * hh; }
DI bf16x8 pack8(float a0, float a1, float a2, float a3, float a4, float a5, float a6, float a7) {
    u32x4 p; p.x = pk2(a0, a1); p.y = pk2(a2, a3); p.z = pk2(a4, a5); p.w = pk2(a6, a7);
    return __builtin_bit_cast(bf16x8, p);
}
DI f32x16 zero16() { f32x16 z;
#pragma unroll
    for (int i = 0; i < 16; ++i) z[i] = 0.f;
    return z; }

#define XB_TMO      128
#define XB_XCNT(j)  (256  + 64 * (j))
#define XB_XSUB(j)  (1280 + 64 * (j))
#define XB_XGEN(j)  (2304 + 64 * (j))
#define XB_TOP      3328
#define XB_TOPGEN   3392
#define XCD_BAR_WORDS 3456
#define XB_SPIN_CAP (1u << 18)
#define LAS __attribute__((address_space(3)))

__device__ __forceinline__ unsigned xb_ld(unsigned* p)              { return __hip_atomic_load(p, __ATOMIC_RELAXED, __HIP_MEMORY_SCOPE_AGENT); }
__device__ __forceinline__ unsigned xb_add(unsigned* p, unsigned v) { return __hip_atomic_fetch_add(p, v, __ATOMIC_RELAXED, __HIP_MEMORY_SCOPE_AGENT); }
__device__ __forceinline__ unsigned xb_xcc_id() { return (unsigned)__builtin_amdgcn_s_getreg((3 << 11) | 20) & 0xFu; }
#define XB_SPIN(cond, bar) do { unsigned _sp = 0; while (cond) { __builtin_amdgcn_s_sleep(1); \
    if ((++_sp & 255u) == 0u) { if (xb_ld(&(bar)[XB_TMO])) break; if (_sp > XB_SPIN_CAP) { atomicAdd(&(bar)[XB_TMO], 1u); break; } } } } while (0)

struct XcdBarrier {
    unsigned* bar; unsigned x;
    volatile LAS unsigned* st;
};

__device__ __forceinline__ XcdBarrier xcd_barrier_post(unsigned* bar, volatile LAS unsigned* st, bool leader) {
    XcdBarrier b; b.bar = bar; b.x = xb_xcc_id(); b.st = st;
    if (leader) (void)xb_add(&bar[XB_XCNT(b.x)], 1u);
    return b;
}
__device__ __forceinline__ void xcd_barrier_complete(unsigned* bar, unsigned x, unsigned& nloc, unsigned& nx) {
    const unsigned G = gridDim.x * gridDim.y * gridDim.z;
    unsigned sum, cnt, mine, sp = 0u;
    for (;;) {
        sum = 0u; cnt = 0u; mine = 0u;
#pragma unroll
        for (unsigned j = 0; j < 16; ++j) { const unsigned c = xb_ld(&bar[XB_XCNT(j)]); sum += c; cnt += (c > 0u) ? 1u : 0u; mine = (j == x) ? c : mine; }
        if (sum == G) break;
        __builtin_amdgcn_s_sleep(1);
        if ((++sp & 255u) == 0u) { if (xb_ld(&bar[XB_TMO])) break; if (sp > XB_SPIN_CAP) { atomicAdd(&bar[XB_TMO], 1u); break; } }
    }
    nloc = mine > 0u ? mine : 1u; nx = cnt > 0u ? cnt : 1u;
}

__device__ __forceinline__ void xcd_barrier(const XcdBarrier& b, bool leader) {
    asm volatile("s_waitcnt vmcnt(0)" ::: "memory");
    __syncthreads();
    if (leader) {
        unsigned* bar = b.bar;
        __builtin_amdgcn_s_waitcnt(0);
        unsigned nloc = b.st[0], nx = b.st[1];
        if (nloc == 0u) { xcd_barrier_complete(bar, b.x, nloc, nx); b.st[0] = nloc; b.st[1] = nx; }
        const unsigned old = xb_add(&bar[XB_XSUB(b.x)], 1u);
        const unsigned gen = old / nloc;
        if (old + 1u == (gen + 1u) * nloc) {
            __builtin_amdgcn_fence(__ATOMIC_RELEASE, "agent");
            asm volatile("s_waitcnt vmcnt(0)" ::: "memory");
            const unsigned og = xb_add(&bar[XB_TOP], 1u);
            const unsigned tg = og / nx;
            if (og + 1u == (tg + 1u) * nx) xb_add(&bar[XB_TOPGEN], 1u);
            else XB_SPIN(xb_ld(&bar[XB_TOPGEN]) == tg, bar);
            __builtin_amdgcn_fence(__ATOMIC_ACQUIRE, "agent");
            xb_add(&bar[XB_XGEN(b.x)], 1u);
            asm volatile("s_waitcnt vmcnt(0)" ::: "memory");
        } else {
            XB_SPIN(xb_ld(&bar[XB_XGEN(b.x)]) == gen, bar);
            __builtin_amdgcn_fence(__ATOMIC_ACQUIRE, "agent");
            asm volatile("s_waitcnt vmcnt(0)" ::: "memory");
        }
    }
    __syncthreads();
}


DI void phase_prep(const Params& p, char* lds, int wv) {
    const int tid = otid(wv), lane = tid & 63, w = __builtin_amdgcn_readfirstlane(tid >> 6);
    u16* HB = (u16*)p.out;
    u16* WIT = HB + (size_t)M_TOK * 1024;
    u16* WOT = (u16*)(p.ws + OFF_WOT);
    const int nwaves = gridDim.x * 8;
    {
        f32x4 g4[4], b4[4], nx[4];
#pragma unroll
        for (int j = 0; j < 4; ++j) { g4[j] = *(const f32x4*)(p.ln_emb_g + j * 256 + lane * 4); b4[j] = *(const f32x4*)(p.ln_emb_b + j * 256 + lane * 4); }
        int row = blockIdx.x * 8 + w;
        if (row < M_TOK) {
#pragma unroll
            for (int j = 0; j < 4; ++j) nx[j] = __builtin_nontemporal_load((const f32x4*)(p.x + (size_t)row * 1024 + j * 256 + lane * 4));
        }
        for (; row < M_TOK; row += nwaves) {
            f32x4 v[4];
#pragma unroll
            for (int j = 0; j < 4; ++j) v[j] = nx[j];
            if (row + nwaves < M_TOK) {
#pragma unroll
                for (int j = 0; j < 4; ++j) nx[j] = __builtin_nontemporal_load((const f32x4*)(p.x + (size_t)(row + nwaves) * 1024 + j * 256 + lane * 4));
            }
            float s = 0.f;
#pragma unroll
            for (int j = 0; j < 4; ++j) s += v[j][0] + v[j][1] + v[j][2] + v[j][3];
            s = wsum(s);
            const float mean = s * (1.f / 1024.f);
            float q = 0.f;
#pragma unroll
            for (int j = 0; j < 4; ++j)
#pragma unroll
                for (int e = 0; e < 4; ++e) { float d = v[j][e] - mean; q += d * d; }
            q = wsum(q);
            const float rstd = rsqrtf(q * (1.f / 1024.f) + 1e-5f);
#pragma unroll
            for (int j = 0; j < 4; ++j) {
                f32x4 h;
#pragma unroll
                for (int e = 0; e < 4; ++e) h[e] = (v[j][e] - mean) * rstd * g4[j][e] + b4[j][e];
                u32x2 o; o.x = pk2(h[0], h[1]); o.y = pk2(h[2], h[3]);
                *(u32x2*)(HB + (size_t)row * 1024 + j * 256 + lane * 4) = o;
            }
        }
    }
    u16* T = (u16*)lds;
    const int n_tiles_in = 105 * 16, n_tiles_out = 16 * 32;
    for (int t = blockIdx.x; t < n_tiles_in + n_tiles_out; t += gridDim.x) {
        const float* W; int ldw, nsrc, k0, n0, ldd; u16* dst; bool isin = t < n_tiles_in;
        if (isin) { W = p.w_in; ldw = 6688; nsrc = 6688; k0 = (t & 15) * 64; n0 = (t >> 4) * 64; dst = WIT; ldd = 1024; }
        else { int u = t - n_tiles_in; W = p.w_out; ldw = 1024; nsrc = 1024; k0 = (u & 31) * 64; n0 = (u >> 5) * 64; dst = WOT; ldd = 2048; }
#pragma unroll
        for (int i = 0; i < 2; ++i) {
            const int e = tid + 512 * i, k = e >> 4, n4 = (e & 15) * 4;
            f32x4 v = {0.f, 0.f, 0.f, 0.f};
            if (n0 + n4 < nsrc) v = __builtin_nontemporal_load((const f32x4*)(W + (size_t)(k0 + k) * ldw + n0 + n4));
#pragma unroll
            for (int q = 0; q < 4; ++q) T[(n4 + q) * 66 + k] = tobf(v[q]);
        }
        __syncthreads();
        {
            const int n = tid >> 3, kc = (tid & 7) * 8, ns = n0 + n;
            if (ns < nsrc) {
                int nd = ns;
                if (isin) nd = (ns < 2560) ? ns : (ns < 2592) ? (ns + 3072) : (ns < 4640) ? (ns - 32) : (ns < 5664) ? (ns + 1248) : (ns - 1056);
                const unsigned* tp = (const unsigned*)(T + n * 66 + kc);
                u32x4 o; o.x = tp[0]; o.y = tp[1]; o.z = tp[2]; o.w = tp[3];
                *(u32x4*)(dst + (size_t)nd * ldd + k0 + kc) = o;
            }
        }
        __syncthreads();
    }
    if (blockIdx.x == 0) { if (tid < 128) ((unsigned*)(p.ws + OFF_KN))[tid] = 0u;
        for (int e = tid; e < 4096; e += 512) ((unsigned*)(p.ws + OFF_BAR))[e] = 0u; }
    for (int e = blockIdx.x * 512 + tid; e < 224 * 512; e += gridDim.x * 512) ((unsigned*)(WIT + (size_t)5664 * 1024))[e] = 0u;
}

namespace pg8 {
#define PG8_LAS __attribute__((address_space(3)))
typedef unsigned short bf16_t;
typedef short bf16x8 __attribute__((ext_vector_type(8)));
typedef float f32x4 __attribute__((ext_vector_type(4)));
typedef unsigned u32x4 __attribute__((ext_vector_type(4)));
constexpr int BM = 256, BK = 64, HALF = 128, HTB = HALF * BK * 2  , STAGE_BYTES = 8 * HTB, NXCD = 8, WGM = 8;

__host__ __device__ __forceinline__ int lds_byte(int r, int c) { const int st = (r >> 4) * 2 + (c >> 5), rr = r & 15, cc = c & 31, ob = rr * 64 + cc * 2; return st * 1024 + (ob ^ (((ob >> 9) & 1) << 5)); }
__host__ __device__ __forceinline__ void stage_rc(int b, int& R, int& C) { const int st = b / 1024, sb = b % 1024, swz = sb ^ (((sb >> 9) & 1) << 5); R = (st >> 1) * 16 + swz / 64; C = (st & 1) * 32 + (swz % 64) / 2; }
__host__ __device__ __forceinline__ int perm32(int rho) { const int n = rho >> 4, i = rho & 15; return 8 * (i >> 2) + 4 * n + (i & 3); }

struct Unit { int pm, pn; };
struct Gemm { const bf16_t* A; const bf16_t* A1; const bf16_t* Bt; int M, N, K, lda, ksplit; };

struct StaticOrder {
    int nM, nN, nwg, G, c;
    __host__ __device__ void init(int M, int N, int G_, int c_) { nM = M / BM; nN = N / BM; nwg = nM * nN; G = G_; c = c_; }
    __host__ __device__ bool next(int i, Unit& u) const {
        const long L = (long)i * G + c; if (L >= nwg) return false;
        int wgid = (int)L; { const int q = nwg / NXCD, r = nwg % NXCD, xcd = wgid % NXCD, off = wgid / NXCD; wgid = (xcd < r ? xcd * (q + 1) : r * (q + 1) + (xcd - r) * q) + off; }
        const int nig = WGM * nN, gid = wgid / nig, fm = gid * WGM, gsz = (nM - fm) < WGM ? (nM - fm) : WGM;
        u.pm = fm + ((wgid % nig) % gsz); u.pn = (wgid % nig) / gsz; return true;
    }
    __device__ __forceinline__ void a_ready(const Unit&) const {}
    __device__ __forceinline__ void done(const Unit&) const {}
};
template <class Epi, class Sched, bool ALIGN_EPI = false, bool SP2 = false>
__device__ __forceinline__ void gemm_phase(PG8_LAS unsigned char* lds, const Gemm g, const Sched& S, const Epi& E, int wv) {
    const int tid = otid(wv), wid = __builtin_amdgcn_readfirstlane(tid >> 6), lane = tid & 63, wr = wid >> 2, wc = wid & 3, fr = lane & 15, fq = lane >> 4;
    const int K = g.K, nt = K / BK;
    unsigned voffA[2], voffB[2];
#pragma unroll
    for (int i = 0; i < 2; ++i) { int R, C; stage_rc(tid * 16 + i * 8192, R, C); const int Rb = Epi::PERM ? ((R & ~31) + perm32(R & 31)) : R;
        voffA[i] = (unsigned)(R * g.lda + C) * 2u; voffB[i] = (unsigned)(Rb * K + C) * 2u; }
    const size_t kstep = (size_t)(BK * 2);
    const size_t hstep = (size_t)HALF * K * 2;
    const size_t tstep = 2 * hstep;
    const size_t hstepA = (size_t)HALF * g.lda * 2, tstepA = 2 * hstepA;
    const int ksp = g.ksplit;
#define PG8_AP(b0, b1, t_) (((t_) < ksp) ? ((b0) + (size_t)(t_) * kstep) : ((b1) + (size_t)((t_) - ksp) * kstep))
    const unsigned ldsw = (unsigned)wid * 1024u;
    const int aoff = lds_byte(wr * 64 + fr, fq * 8), boff = lds_byte(wc * 32 + fr, fq * 8);
#define PG8_SA(b, h) (((b) * 2 + (h)) * HTB)
#define PG8_SB(b, h) ((4 + (b) * 2 + (h)) * HTB)
#define PG8_STAGE(bufoff, gbase, voff) do { _Pragma("unroll") for (int _i = 0; _i < 2; ++_i) \
        __builtin_amdgcn_global_load_lds((const unsigned*)((const char*)(gbase) + (voff)[_i]), (PG8_LAS unsigned*)(lds + (bufoff) + ldsw + _i * 8192), 16, 0, 0); } while (0)
#define PG8_LDA(dst, b, h) do { _Pragma("unroll") for (int m = 0; m < 4; ++m) _Pragma("unroll") for (int k = 0; k < 2; ++k) dst[m][k] = *(const PG8_LAS bf16x8*)(lds + PG8_SA(b, h) + aoff + m * 2048 + k * 1024); } while (0)
#define PG8_LDB(dst, b, h) do { _Pragma("unroll") for (int n = 0; n < 2; ++n) _Pragma("unroll") for (int k = 0; k < 2; ++k) dst[n][k] = *(const PG8_LAS bf16x8*)(lds + PG8_SB(b, h) + boff + n * 2048 + k * 1024); } while (0)
#define PG8_MMA(ai, bj, At, Bt) do { __builtin_amdgcn_s_setprio(1); _Pragma("unroll") for (int m = 0; m < 4; ++m) _Pragma("unroll") for (int n = 0; n < 2; ++n) _Pragma("unroll") for (int k = 0; k < 2; ++k) \
        acc[ai][bj][m][n] = __builtin_amdgcn_mfma_f32_16x16x32_bf16(Bt[n][k], At[m][k], acc[ai][bj][m][n], 0, 0, 0); __builtin_amdgcn_s_setprio(0); } while (0)
#define PG8_WAIT_V(n) asm volatile("s_waitcnt vmcnt(" #n ")" ::: "memory")
#define PG8_WAIT_L(n) asm volatile("s_waitcnt lgkmcnt(" #n ")" ::: "memory")
#define PG8_BAR __builtin_amdgcn_s_barrier()
#define PG8_SCHED __builtin_amdgcn_sched_barrier(0)
    Unit cur, nxt; int ui = 0;
    if (!S.next(0, cur)) return;
    f32x4 acc[2][2][4][2];
#pragma unroll
    for (int a = 0; a < 2; ++a)
#pragma unroll
        for (int b = 0; b < 2; ++b)
#pragma unroll
            for (int m = 0; m < 4; ++m)
#pragma unroll
                for (int n = 0; n < 2; ++n) acc[a][b][m][n] = (f32x4){0.f, 0.f, 0.f, 0.f};
    bf16x8 At[4][2], B0[2][2], B1[2][2];
    const char* cA = (const char*)g.A + (size_t)cur.pm * tstepA; const char* cA1 = (const char*)g.A1 + (size_t)cur.pm * tstepA; const char* cB = (const char*)g.Bt + (size_t)cur.pn * tstep;
    S.a_ready(cur);
    if constexpr (SP2) {
        PG8_STAGE(PG8_SB(0, 0), cB, voffB); PG8_STAGE(PG8_SB(0, 1), cB + hstep, voffB); PG8_STAGE(PG8_SA(0, 0), cA, voffA); PG8_STAGE(PG8_SA(0, 1), cA + hstepA, voffA);
        if (wr == 1) PG8_BAR;
        PG8_WAIT_V(2); PG8_BAR;
        PG8_STAGE(PG8_SB(1, 0), cB + kstep, voffB); PG8_STAGE(PG8_SA(1, 0), PG8_AP(cA, cA1, 1), voffA); PG8_STAGE(PG8_SB(1, 1), cB + hstep + kstep, voffB);
        PG8_WAIT_V(6); PG8_BAR;
    } else {
        PG8_STAGE(PG8_SB(0, 0), cB, voffB); PG8_STAGE(PG8_SA(0, 0), cA, voffA); PG8_STAGE(PG8_SB(0, 1), cB + hstep, voffB); PG8_STAGE(PG8_SA(0, 1), cA + hstepA, voffA);
        if (wr == 1) PG8_BAR;
        PG8_WAIT_V(4); PG8_BAR;
        PG8_STAGE(PG8_SB(1, 0), cB + kstep, voffB); PG8_STAGE(PG8_SA(1, 0), PG8_AP(cA, cA1, 1), voffA); PG8_STAGE(PG8_SB(1, 1), cB + hstep + kstep, voffB);
        PG8_WAIT_V(6); PG8_BAR;
    }
    for (;;) {
        const bool has_next = S.next(ui + 1, nxt);
        const char* nA = has_next ? (const char*)g.A + (size_t)nxt.pm * tstepA : cA; const char* nA1 = has_next ? (const char*)g.A1 + (size_t)nxt.pm * tstepA : cA1; const char* nB = has_next ? (const char*)g.Bt + (size_t)nxt.pn * tstep : cB;
        for (int t = 0; t < nt; t += 2) {
            const bool last = (t == nt - 2);
            const char* a1 = PG8_AP(cA, cA1, t + 1);
            const char* a2 = last ? nA : PG8_AP(cA, cA1, t + 2); const char* b2 = last ? nB : cB + (size_t)(t + 2) * kstep;
            const char* a3 = a2 + kstep; const char* b3 = b2 + kstep;
            if (last && has_next) S.a_ready(nxt);
            if constexpr (SP2) {
            PG8_LDB(B0, 0, 0); PG8_LDB(B1, 0, 1); PG8_SCHED; PG8_LDA(At, 0, 0); PG8_STAGE(PG8_SA(1, 1), a1 + hstepA, voffA);
            PG8_WAIT_V(8); PG8_WAIT_L(0); PG8_BAR; PG8_MMA(0, 0, At, B0); PG8_MMA(0, 1, At, B1); PG8_BAR; PG8_SCHED;
            PG8_LDA(At, 0, 1); PG8_STAGE(PG8_SB(0, 0), b2, voffB); PG8_STAGE(PG8_SB(0, 1), b2 + hstep, voffB); PG8_STAGE(PG8_SA(0, 0), a2, voffA);
            PG8_WAIT_V(8); PG8_WAIT_L(0); PG8_BAR; PG8_MMA(1, 0, At, B0); PG8_MMA(1, 1, At, B1); PG8_BAR; PG8_SCHED;
            PG8_LDB(B0, 1, 0); PG8_LDB(B1, 1, 1); PG8_SCHED; PG8_LDA(At, 1, 0); PG8_STAGE(PG8_SA(0, 1), a2 + hstepA, voffA);
            PG8_WAIT_V(8); PG8_WAIT_L(0); PG8_BAR; PG8_MMA(0, 0, At, B0); PG8_MMA(0, 1, At, B1); PG8_BAR; PG8_SCHED;
            PG8_LDA(At, 1, 1); PG8_STAGE(PG8_SB(1, 0), b3, voffB); PG8_STAGE(PG8_SB(1, 1), b3 + hstep, voffB); PG8_STAGE(PG8_SA(1, 0), a3, voffA);
            PG8_WAIT_V(8); PG8_WAIT_L(0); PG8_BAR; PG8_MMA(1, 0, At, B0); PG8_MMA(1, 1, At, B1); PG8_BAR; PG8_SCHED;
            } else {
            PG8_LDB(B0, 0, 0); PG8_SCHED; PG8_LDA(At, 0, 0); PG8_STAGE(PG8_SA(1, 1), a1 + hstepA, voffA);
            PG8_WAIT_L(8); PG8_BAR; PG8_WAIT_L(0); PG8_MMA(0, 0, At, B0); PG8_BAR; PG8_SCHED;
            PG8_LDB(B1, 0, 1); PG8_STAGE(PG8_SB(0, 0), b2, voffB);
            PG8_BAR; PG8_WAIT_L(0); PG8_MMA(0, 1, At, B1); PG8_BAR;
            PG8_LDA(At, 0, 1); PG8_STAGE(PG8_SA(0, 0), a2, voffA);
            PG8_BAR; PG8_WAIT_L(0); PG8_MMA(1, 0, At, B0); PG8_BAR; PG8_SCHED;
            PG8_STAGE(PG8_SB(0, 1), b2 + hstep, voffB);
            PG8_WAIT_V(6); PG8_BAR; PG8_MMA(1, 1, At, B1); PG8_BAR;
            PG8_LDB(B0, 1, 0); PG8_SCHED; PG8_LDA(At, 1, 0); PG8_STAGE(PG8_SA(0, 1), a2 + hstepA, voffA);
            PG8_WAIT_L(8); PG8_BAR; PG8_WAIT_L(0); PG8_MMA(0, 0, At, B0); PG8_BAR; PG8_SCHED;
            PG8_LDB(B1, 1, 1); PG8_STAGE(PG8_SB(1, 0), b3, voffB);
            PG8_BAR; PG8_WAIT_L(0); PG8_MMA(0, 1, At, B1); PG8_BAR;
            PG8_LDA(At, 1, 1); PG8_STAGE(PG8_SA(1, 0), a3, voffA);
            PG8_BAR; PG8_WAIT_L(0); PG8_MMA(1, 0, At, B0); PG8_BAR; PG8_SCHED;
            PG8_STAGE(PG8_SB(1, 1), b3 + hstep, voffB);
            PG8_WAIT_V(6); PG8_BAR; PG8_MMA(1, 1, At, B1); PG8_BAR;
            }
        }
        if constexpr (ALIGN_EPI) { if (wr == 0) PG8_BAR; }
        if constexpr (!Epi::AFTER_DRAIN) { E(acc, cur, wr, wc, fr, fq); S.done(cur); }
        if (!has_next) break;
#pragma unroll
        for (int a = 0; a < 2; ++a)
#pragma unroll
            for (int b = 0; b < 2; ++b)
#pragma unroll
                for (int m = 0; m < 4; ++m)
#pragma unroll
                    for (int n = 0; n < 2; ++n) acc[a][b][m][n] = (f32x4){0.f, 0.f, 0.f, 0.f};
        cur = nxt; cA = nA; cA1 = nA1; cB = nB; ++ui;
        if constexpr (ALIGN_EPI) { if (wr == 1) PG8_BAR; }
    }
    PG8_WAIT_V(0);
    if constexpr (!ALIGN_EPI) { if (wr == 0) PG8_BAR; }
    PG8_BAR;
    if constexpr (Epi::AFTER_DRAIN) { E.fused(acc, cur, wr, wc, fr, fq, lds, wid, lane); S.done(cur); }
#undef PG8_AP
#undef PG8_SA
#undef PG8_SB
#undef PG8_STAGE
#undef PG8_LDA
#undef PG8_LDB
#undef PG8_MMA
#undef PG8_WAIT_V
#undef PG8_WAIT_L
#undef PG8_BAR
#undef PG8_SCHED
}
}


struct EpiProj {
    static constexpr bool PERM = true, AFTER_DRAIN = false;
    char* ws;
    DI void operator()(const pg8::f32x4 (&acc)[2][2][4][2], const pg8::Unit& u, int wr, int wc, int fr, int fq) const {
        const int pn = u.pn, row0 = u.pm * 256 + wr * 64 + fr;
        if (pn < 22) {
            u16* dst; int ld, cb; float sc = 1.f; const bool isk = (pn >= 14 && pn < 18);
            if (pn < 4) { dst = (u16*)(ws + OFF_Z); ld = 1024; cb = pn * 256; }
            else if (pn < 10) { dst = (u16*)(ws + OFF_XBC); ld = 1536; cb = (pn - 4) * 256; }
            else if (pn < 14) { dst = (u16*)(ws + OFF_Q); ld = 1024; cb = (pn - 10) * 256; sc = 0.125f * LOG2E; }
            else if (pn < 18) { dst = (u16*)(ws + OFF_K); ld = 128; cb = 0; }
            else { dst = (u16*)(ws + OFF_G); ld = 1024; cb = (pn - 18) * 256; }
#pragma unroll
            for (int ai = 0; ai < 2; ++ai)
#pragma unroll
                for (int m = 0; m < 4; ++m) {
                    const int r = row0 + ai * 128 + m * 16;
#pragma unroll
                    for (int bj = 0; bj < 2; ++bj) {
                        const size_t rowaddr = isk ? ((size_t)((r >> 13) * 8 + (pn - 14) * 2 + bj) * 8192 + (r & 8191)) : (size_t)r;
                        const int col = isk ? (wc * 32 + 8 * fq) : (cb + bj * 128 + wc * 32 + 8 * fq);
                        const pg8::f32x4 v0 = acc[ai][bj][m][0], v1 = acc[ai][bj][m][1];
                        u32x4 wv4; wv4.x = pk2(v0[0] * sc, v0[1] * sc); wv4.y = pk2(v0[2] * sc, v0[3] * sc); wv4.z = pk2(v1[0] * sc, v1[1] * sc); wv4.w = pk2(v1[2] * sc, v1[3] * sc);
                        *(u32x4*)(dst + rowaddr * ld + col) = wv4;
                    }
                }
        } else if (wc == 0) {
            float* DT = (float*)(ws + OFF_DT);
#pragma unroll
            for (int ai = 0; ai < 2; ++ai)
#pragma unroll
                for (int m = 0; m < 4; ++m) {
                    const int r = row0 + ai * 128 + m * 16;
                    *(f32x4*)(DT + (size_t)r * 32 + 8 * fq) = acc[ai][0][m][0];
                    *(f32x4*)(DT + (size_t)r * 32 + 8 * fq + 4) = acc[ai][0][m][1];
                }
        }
    }
};
struct EpiVT {
    static constexpr bool PERM = true, AFTER_DRAIN = false;
    char* ws;
    DI void operator()(const pg8::f32x4 (&acc)[2][2][4][2], const pg8::Unit& u, int wr, int wc, int fr, int fq) const {
        u16* VT = (u16*)(ws + OFF_VT);
#pragma unroll
        for (int ai = 0; ai < 2; ++ai)
#pragma unroll
            for (int m = 0; m < 4; ++m) {
                const int eg = u.pm * 256 + ai * 128 + wr * 64 + m * 16 + fr, head = eg >> 7, e = eg & 127;
#pragma unroll
                for (int bj = 0; bj < 2; ++bj) {
                    const int tok = u.pn * 256 + bj * 128 + wc * 32 + 8 * fq, b = tok >> 13, t = tok & 8191;
                    const pg8::f32x4 v0 = acc[ai][bj][m][0], v1 = acc[ai][bj][m][1];
                    u32x4 wv4; wv4.x = pk2(v0[0], v0[1]); wv4.y = pk2(v0[2], v0[3]); wv4.z = pk2(v1[0], v1[1]); wv4.w = pk2(v1[2], v1[3]);
                    u16* vp = VT + ((size_t)((b * 8 + head) * 128 + (t >> 6))) * 8192 + e * 64 + (t & 48) + ((t >> 3) & 1) * 4;
                    u32x2 lo2, hi2; lo2.x = wv4.x; lo2.y = wv4.y; hi2.x = wv4.z; hi2.y = wv4.w;
                    *(u32x2*)vp = lo2; *(u32x2*)(vp + 8) = hi2;
                }
            }
    }
};
struct EpiOut {
    static constexpr bool PERM = true, AFTER_DRAIN = false;
    u16* mix;
    DI void operator()(const pg8::f32x4 (&acc)[2][2][4][2], const pg8::Unit& u, int wr, int wc, int fr, int fq) const {
#pragma unroll
        for (int ai = 0; ai < 2; ++ai)
#pragma unroll
            for (int m = 0; m < 4; ++m) {
                const int r = u.pm * 256 + ai * 128 + wr * 64 + m * 16 + fr;
#pragma unroll
                for (int bj = 0; bj < 2; ++bj) {
                    const pg8::f32x4 v0 = acc[ai][bj][m][0], v1 = acc[ai][bj][m][1];
                    u32x4 wv4; wv4.x = pk2(v0[0], v0[1]); wv4.y = pk2(v0[2], v0[3]); wv4.z = pk2(v1[0], v1[1]); wv4.w = pk2(v1[2], v1[3]);
                    *(u32x4*)(mix + (size_t)r * 1024 + u.pn * 256 + bj * 128 + wc * 32 + 8 * fq) = wv4;
                }
            }
    }
};

DI void phase_gemm1(const Params& p, char* lds, int wv) {
    const u16* HB = (const u16*)p.out;
    const u16* WIT = HB + (size_t)M_TOK * 1024;
    PG8_LAS unsigned char* l3 = (PG8_LAS unsigned char*)lds;
    pg8::StaticOrder S;
    {
        const pg8::Gemm g{HB, HB, WIT, M_TOK, 5888, 1024, 1024, 1 << 20};
        S.init(M_TOK, 5888, gridDim.x, blockIdx.x);
        pg8::gemm_phase<EpiProj, pg8::StaticOrder, true, true>(l3, g, S, EpiProj{p.ws}, wv);
    }
    {
        const pg8::Gemm g{WIT + (size_t)5888 * 1024, WIT + (size_t)5888 * 1024, HB, 1024, M_TOK, 1024, 1024, 1 << 20};
        S.init(1024, M_TOK, gridDim.x, blockIdx.x);
        pg8::gemm_phase<EpiVT, pg8::StaticOrder, true, true>(l3, g, S, EpiVT{p.ws}, wv);
    }
}

DI unsigned pair_pack(float x0, float x1, int odd) {
    const float send = odd ? x0 : x1;
    const float recv = __builtin_bit_cast(float, __builtin_amdgcn_mov_dpp(__builtin_bit_cast(int, send), 0xB1, 0xF, 0xF, true));
    return odd ? pk2(recv, x1) : pk2(x0, recv);
}

DI void ssdA_item(const Params& p, int item, char* lds, int wv) {
    const int tid = otid(wv), lane = tid & 63, w = __builtin_amdgcn_readfirstlane(tid >> 6), l31 = lane & 31, hh = lane >> 5;
    const int g = item & 1, c = (item >> 1) & 63, b = item >> 7;
    const int t0 = b * 8192 + c * 128;
    char* sB = lds; char* sC = lds + 34816; char* sBT = lds + 69632;
    float* tab = (float*)(lds + 104448);
    float* t_af = tab; float* t_ab = tab + 1024; float* t_df = tab + 2048; float* t_db = tab + 3072;
    float* part = (float*)(lds + 120832);
    const u16* XBC = (const u16*)(p.ws + OFF_XBC);
    const float* DT = (const float*)(p.ws + OFF_DT);
    float* EA = (float*)(p.ws + OFF_EA);
    float* DEC = (float*)(p.ws + OFF_DEC);
    u16* YL = (u16*)(p.ws + OFF_YL);
    u16* ST = (u16*)p.out;
    {
        const int j = w, hd = g * 8 + j;
#pragma unroll
        for (int dir = 0; dir < 2; ++dir) {
            const float A = -expf(dir ? p.A_log_b[hd] : p.A_log_f[hd]) * LOG2E;
            const float bias = dir ? p.dt_bias_b[hd] : p.dt_bias_f[hd];
            const int col = dir * 16 + hd;
            const float d0 = softplusf(DT[(size_t)(t0 + lane) * 32 + col] + bias);
            const float d1 = softplusf(DT[(size_t)(t0 + lane + 64) * 32 + col] + bias);
            const float a0 = d0 * A, a1 = d1 * A;
            float s0 = a0, s1 = a1;
#pragma unroll
            for (int o = 1; o < 64; o <<= 1) {
                const float u0 = __shfl_up(s0, o), u1 = __shfl_up(s1, o);
                if (lane >= o) { s0 += u0; s1 += u1; }
            }
            const float tot0 = __shfl(s0, 63);
            s1 += tot0;
            const float total = __shfl(s1, 63);
            float e0, e1;
            if (dir == 0) { e0 = s0; e1 = s1; t_af[j * 128 + lane] = e0; t_af[j * 128 + lane + 64] = e1; t_df[j * 128 + lane] = d0; t_df[j * 128 + lane + 64] = d1; }
            else { e0 = total - (s0 - a0); e1 = total - (s1 - a1); t_ab[j * 128 + lane] = e0; t_ab[j * 128 + lane + 64] = e1; t_db[j * 128 + lane] = d0; t_db[j * 128 + lane + 64] = d1; }
            EA[(size_t)(t0 + lane) * 32 + col] = exp2f(e0);
            EA[(size_t)(t0 + lane + 64) * 32 + col] = exp2f(e1);
            if (lane == 0) DEC[((b * 16 + hd) * 2 + dir) * 64 + c] = exp2f(total);
        }
    }
    {
        const int cp = tid & 127, tg = tid >> 7;
        const bool isC = cp >= 64; const int n = 2 * (cp & 63);
        const int col = (isC ? 1280 : 1024) + g * 128 + n;
        float w0[5], w1[5];
#pragma unroll
        for (int k = 0; k < 5; ++k) { w0[k] = p.conv_w[k * 1536 + col]; w1[k] = p.conv_w[k * 1536 + col + 1]; }
        const float b0 = p.conv_b[col], b1 = p.conv_b[col + 1];
#pragma unroll 1
        for (int half = 0; half < 2; ++half) {
            const int lbase = tg * 32 + half * 16;
            unsigned win[20];
#pragma unroll
            for (int i = 0; i < 20; ++i) {
                const int lt = lbase - 2 + i, ts = c * 128 + lt;
                win[i] = (ts >= 0 && ts < 8192) ? *(const unsigned*)(XBC + (size_t)(t0 + lt) * 1536 + col) : 0u;
            }
#pragma unroll
            for (int i = 0; i < 16; ++i) {
                const int l = lbase + i;
                float v0 = b0, v1 = b1;
#pragma unroll
                for (int k = 0; k < 5; ++k) { v0 += w0[k] * bflo(win[i + k]); v1 += w1[k] * bfhi(win[i + k]); }
                v0 = siluf(v0); v1 = siluf(v1);
                const unsigned u = pk2(v0, v1);
                if (!isC) {
                    *(unsigned*)(sB + l * 272 + n * 2) = u;
                    *(u16*)(sBT + n * 272 + l * 2) = (u16)(u & 0xffffu);
                    *(u16*)(sBT + (n + 1) * 272 + l * 2) = (u16)(u >> 16);
                } else *(unsigned*)(sC + l * 272 + n * 2) = u;
            }
        }
    }
    __syncthreads();
    const int lb = w & 3, sh = w >> 2;
    f32x16 cbt[2];
#pragma unroll
    for (int sbl = 0; sbl < 2; ++sbl) {
        cbt[sbl] = zero16();
#pragma unroll
        for (int ks = 0; ks < 8; ++ks) {
            const bf16x8 a = *(const bf16x8*)(sB + ((sh * 2 + sbl) * 32 + l31) * 272 + (ks * 16 + hh * 8) * 2);
            const bf16x8 bq = *(const bf16x8*)(sC + (lb * 32 + l31) * 272 + (ks * 16 + hh * 8) * 2);
            cbt[sbl] = MFMA(a, bq, cbt[sbl]);
        }
    }
    __syncthreads();
    char* sX = lds; char* sXF = lds + 17408; char* sXB = lds + 34816;
    unsigned winn[12];
    {
        const int cp = tid & 31, tg = tid >> 5, lbase = tg * 8, col = (g * 8) * 64 + 2 * cp;
#pragma unroll
        for (int i = 0; i < 12; ++i) {
            const int lt = lbase - 2 + i, ts = c * 128 + lt;
            winn[i] = (ts >= 0 && ts < 8192) ? *(const unsigned*)(XBC + (size_t)(t0 + lt) * 1536 + col) : 0u;
        }
    }
#pragma unroll 1
    for (int j = 0; j < 8; ++j) {
        const int hd = g * 8 + j;
        {
            const int cp = tid & 31, tg = tid >> 5;
            const int col = hd * 64 + 2 * cp;
            float w0[5], w1[5];
#pragma unroll
            for (int k = 0; k < 5; ++k) { w0[k] = p.conv_w[k * 1536 + col]; w1[k] = p.conv_w[k * 1536 + col + 1]; }
            const float b0 = p.conv_b[col], b1 = p.conv_b[col + 1];
            const int lbase = tg * 8;
            unsigned win[12];
#pragma unroll
            for (int i = 0; i < 12; ++i) win[i] = winn[i];
            if (j < 7) {
#pragma unroll
                for (int i = 0; i < 12; ++i) {
                    const int lt = lbase - 2 + i, ts = c * 128 + lt;
                    winn[i] = (ts >= 0 && ts < 8192) ? *(const unsigned*)(XBC + (size_t)(t0 + lt) * 1536 + col + 64) : 0u;
                }
            }
            const float afend = t_af[j * 128 + 127], ab0 = t_ab[j * 128];
            float o0[8], o1[8];
#pragma unroll
            for (int i = 0; i < 8; ++i) {
                float v0 = b0, v1 = b1;
#pragma unroll
                for (int k = 0; k < 5; ++k) { v0 += w0[k] * bflo(win[i + k]); v1 += w1[k] * bfhi(win[i + k]); }
                o0[i] = siluf(v0); o1[i] = siluf(v1);
            }
            const int p0 = 2 * cp;
            *(bf16x8*)(sX + p0 * 272 + lbase * 2) = pack8(o0[0], o0[1], o0[2], o0[3], o0[4], o0[5], o0[6], o0[7]);
            *(bf16x8*)(sX + (p0 + 1) * 272 + lbase * 2) = pack8(o1[0], o1[1], o1[2], o1[3], o1[4], o1[5], o1[6], o1[7]);
            float wv[8];
#pragma unroll
            for (int i = 0; i < 8; ++i) wv[i] = t_df[j * 128 + lbase + i] * __builtin_amdgcn_exp2f(afend - t_af[j * 128 + lbase + i]);
            *(bf16x8*)(sXF + p0 * 272 + lbase * 2) = pack8(o0[0] * wv[0], o0[1] * wv[1], o0[2] * wv[2], o0[3] * wv[3], o0[4] * wv[4], o0[5] * wv[5], o0[6] * wv[6], o0[7] * wv[7]);
            *(bf16x8*)(sXF + (p0 + 1) * 272 + lbase * 2) = pack8(o1[0] * wv[0], o1[1] * wv[1], o1[2] * wv[2], o1[3] * wv[3], o1[4] * wv[4], o1[5] * wv[5], o1[6] * wv[6], o1[7] * wv[7]);
#pragma unroll
            for (int i = 0; i < 8; ++i) wv[i] = t_db[j * 128 + lbase + i] * __builtin_amdgcn_exp2f(ab0 - t_ab[j * 128 + lbase + i]);
            *(bf16x8*)(sXB + p0 * 272 + lbase * 2) = pack8(o0[0] * wv[0], o0[1] * wv[1], o0[2] * wv[2], o0[3] * wv[3], o0[4] * wv[4], o0[5] * wv[5], o0[6] * wv[6], o0[7] * wv[7]);
            *(bf16x8*)(sXB + (p0 + 1) * 272 + lbase * 2) = pack8(o1[0] * wv[0], o1[1] * wv[1], o1[2] * wv[2], o1[3] * wv[3], o1[4] * wv[4], o1[5] * wv[5], o1[6] * wv[6], o1[7] * wv[7]);
        }
        __syncthreads();
        f32x16 y[2]; y[0] = zero16(); y[1] = zero16();
        {
            const int l = lb * 32 + l31;
            const float afl = t_af[j * 128 + l], abl = t_ab[j * 128 + l];
            const float Dh = p.D[hd];
#pragma unroll
            for (int sbl = 0; sbl < 2; ++sbl) {
                const int sb = sh * 2 + sbl;
                float dloc = (float)((lb - sb) * 32 + l31 - 4 * hh);
                asm volatile("" : "+v"(dloc));
                float m[16];
#pragma unroll
                for (int grp = 0; grp < 4; ++grp) {
                    const int sbase = sb * 32 + 8 * grp + 4 * hh;
                    const f32x4 afs = *(const f32x4*)(t_af + j * 128 + sbase);
                    const f32x4 dfs = *(const f32x4*)(t_df + j * 128 + sbase);
                    const f32x4 abs_ = *(const f32x4*)(t_ab + j * 128 + sbase);
                    const f32x4 dbs = *(const f32x4*)(t_db + j * 128 + sbase);
#pragma unroll
                    for (int q = 0; q < 4; ++q) {
                        const float dq = dloc - (float)(8 * grp + q);
                        const float fm = __builtin_amdgcn_fmed3f(dq + 1.f, 0.f, 1.f), bm = __builtin_amdgcn_fmed3f(1.f - dq, 0.f, 1.f);
                        const float f = fm * __builtin_amdgcn_exp2f(fminf(afl - afs[q], 0.f)) * dfs[q];
                        const float bw = bm * __builtin_amdgcn_exp2f(fminf(abl - abs_[q], 0.f)) * dbs[q];
                        m[grp * 4 + q] = cbt[sbl][grp * 4 + q] * (f + bw) + fm * bm * Dh;
                    }
                    __builtin_amdgcn_sched_barrier(0);
                }
#pragma unroll
                for (int s2 = 0; s2 < 2; ++s2) {
                    const bf16x8 afrag = pack8(m[8 * s2], m[8 * s2 + 1], m[8 * s2 + 2], m[8 * s2 + 3], m[8 * s2 + 4], m[8 * s2 + 5], m[8 * s2 + 6], m[8 * s2 + 7]);
#pragma unroll
                    for (int pb = 0; pb < 2; ++pb) {
                        const char* xp = sX + (pb * 32 + l31) * 272 + (sb * 32 + 16 * s2 + 4 * hh) * 2;
                        const bf16x4 lo = *(const bf16x4*)xp, hi = *(const bf16x4*)(xp + 16);
                        const bf16x8 bfrag = __builtin_shufflevector(lo, hi, 0, 1, 2, 3, 4, 5, 6, 7);
                        y[pb] = MFMA(afrag, bfrag, y[pb]);
                    }
                }
                __builtin_amdgcn_sched_barrier(0);
            }
            if (sh == 1) {
#pragma unroll
                for (int pb = 0; pb < 2; ++pb)
#pragma unroll
                    for (int i = 0; i < 16; ++i) part[(lb * 32 + pb * 16 + i) * 64 + lane] = y[pb][i];
            }
        }
        {
            const int dir = w & 1, nblk = w >> 1;
            const char* xa = dir ? sXB : sXF;
            f32x16 st[2]; st[0] = zero16(); st[1] = zero16();
#pragma unroll
            for (int ks = 0; ks < 8; ++ks) {
                const bf16x8 bq = *(const bf16x8*)(sBT + (nblk * 32 + l31) * 272 + (ks * 16 + hh * 8) * 2);
#pragma unroll
                for (int pb2 = 0; pb2 < 2; ++pb2) {
                    const bf16x8 a = *(const bf16x8*)(xa + (pb2 * 32 + l31) * 272 + (ks * 16 + hh * 8) * 2);
                    st[pb2] = MFMA(a, bq, st[pb2]);
                }
            }
            u16* dst = ST + ((((size_t)(b * 16 + hd) * 2 + dir) * 64 + c) * 8192);
            const int odd = lane & 1;
#pragma unroll
            for (int pb2 = 0; pb2 < 2; ++pb2)
#pragma unroll
                for (int i = 0; i < 16; i += 2)
                    *(unsigned*)(dst + (pb2 * 32 + crow(i + odd, hh)) * 128 + nblk * 32 + l31 - odd) = pair_pack(st[pb2][i], st[pb2][i + 1], odd);
        }
        __syncthreads();
        if (sh == 0) {
#pragma unroll
            for (int pb = 0; pb < 2; ++pb)
                {
                    float v[16];
#pragma unroll
                    for (int i = 0; i < 16; ++i) v[i] = y[pb][i] + part[(lb * 32 + pb * 16 + i) * 64 + lane];
                    u16* yp = YL + (((((size_t)item * 8 + j) * 4 + lb) * 2 + pb) * 64 + lane) * 16;
                    *(bf16x8*)yp = pack8(v[0], v[1], v[2], v[3], v[4], v[5], v[6], v[7]);
                    *(bf16x8*)(yp + 8) = pack8(v[8], v[9], v[10], v[11], v[12], v[13], v[14], v[15]);
                }
        }
    }
}

DI void phase_scan(const Params& p, int wv) {
    u16* ST = (u16*)p.out;
    const float* DEC = (const float*)(p.ws + OFF_DEC);
    const int nthreads = gridDim.x * 512;
    for (int e = blockIdx.x * 512 + otid(wv); e < 64 * 2048; e += nthreads) {
        const int combo = e >> 11, quad = e & 2047;
        u16* base = ST + (size_t)combo * (64 * 8192) + quad * 4;
        const float* dec = DEC + combo * 64;
        const bool bwd = combo & 1;
        float r0 = 0.f, r1 = 0.f, r2 = 0.f, r3 = 0.f;
        const int c0 = bwd ? 63 : 0, cs = bwd ? -1 : 1;
#pragma unroll 1
        for (int bt = 0; bt < 4; ++bt) {
            u32x2 v[16]; float d[16];
#pragma unroll
            for (int i = 0; i < 16; ++i) { const int ch = c0 + cs * (bt * 16 + i); v[i] = __builtin_nontemporal_load((const u32x2*)(base + (size_t)ch * 8192)); d[i] = dec[ch]; }
#pragma unroll
            for (int i = 0; i < 16; ++i) {
                u32x2 o; o.x = pk2(r0, r1); o.y = pk2(r2, r3);
                r0 = d[i] * r0 + bflo(v[i].x); r1 = d[i] * r1 + bfhi(v[i].x); r2 = d[i] * r2 + bflo(v[i].y); r3 = d[i] * r3 + bfhi(v[i].y);
                v[i] = o;
            }
#pragma unroll
            for (int i = 0; i < 16; ++i) { const int ch = c0 + cs * (bt * 16 + i); *(u32x2*)(base + (size_t)ch * 8192) = v[i]; }
        }
    }
    {
        const int tid = otid(wv), lane = tid & 63, w = __builtin_amdgcn_readfirstlane(tid >> 6);
        const u16* Kg = (const u16*)(p.ws + OFF_K);
        unsigned* KN = (unsigned*)(p.ws + OFF_KN);
        for (int cb = blockIdx.x; cb < 256; cb += gridDim.x) {
            float mx = 0.f;
#pragma unroll 4
            for (int i = 0; i < 8; ++i) {
                const int ch = cb * 64 + w * 8 + i;
                const u32x4 a = *(const u32x4*)(Kg + (size_t)ch * 1024 + lane * 16);
                const u32x4 c = *(const u32x4*)(Kg + (size_t)ch * 1024 + lane * 16 + 8);
                float ss = 0.f;
#pragma unroll
                for (int e = 0; e < 4; ++e) { const float x0 = bflo(a[e]), x1 = bfhi(a[e]), x2 = bflo(c[e]), x3 = bfhi(c[e]); ss += x0 * x0 + x1 * x1 + x2 * x2 + x3 * x3; }
                ss += __shfl_xor(ss, 1); ss += __shfl_xor(ss, 2);
                mx = fmaxf(mx, ss);
            }
#pragma unroll
            for (int o = 4; o < 64; o <<= 1) mx = fmaxf(mx, __shfl_xor(mx, o));
            if (lane == 0) atomicMax(&KN[cb >> 4], __float_as_uint(mx));
        }
    }
}

DI void ssdC_item(const Params& p, int item, char* lds, int wv) {
    const int tid = otid(wv), lane = tid & 63, w = __builtin_amdgcn_readfirstlane(tid >> 6), l31 = lane & 31, hh = lane >> 5;
    const int g = item & 1, c = (item >> 1) & 63, b = item >> 7;
    const int t0 = b * 8192 + c * 128;
    char* sC = lds;
    float* ea = (float*)(lds + 34816);
    float* ssq = ea + 2048;
    float* rs = ssq + 1024;
    const u16* XBC = (const u16*)(p.ws + OFF_XBC);
    const float* EA = (const float*)(p.ws + OFF_EA);
    const u16* YL = (const u16*)(p.ws + OFF_YL);
    u16* Z = (u16*)(p.ws + OFF_Z);
    const u16* ST = (const u16*)p.out;
    for (int idx = tid; idx < 2048; idx += 512) {
        const int l = idx >> 4, cc = idx & 15, dir = cc >> 3, j = cc & 7;
        ea[(dir * 8 + j) * 128 + l] = EA[(size_t)(t0 + l) * 32 + dir * 16 + g * 8 + j];
    }
    {
        const int cp = tid & 63, tg = tid >> 6;
        const int n = 2 * cp, col = 1280 + g * 128 + n;
        float w0[5], w1[5];
#pragma unroll
        for (int k = 0; k < 5; ++k) { w0[k] = p.conv_w[k * 1536 + col]; w1[k] = p.conv_w[k * 1536 + col + 1]; }
        const float b0 = p.conv_b[col], b1 = p.conv_b[col + 1];
        const int lbase = tg * 16;
        unsigned win[20];
#pragma unroll
        for (int i = 0; i < 20; ++i) {
            const int lt = lbase - 2 + i, ts = c * 128 + lt;
            win[i] = (ts >= 0 && ts < 8192) ? *(const unsigned*)(XBC + (size_t)(t0 + lt) * 1536 + col) : 0u;
        }
#pragma unroll
        for (int i = 0; i < 16; ++i) {
            float v0 = b0, v1 = b1;
#pragma unroll
            for (int k = 0; k < 5; ++k) { v0 += w0[k] * bflo(win[i + k]); v1 += w1[k] * bfhi(win[i + k]); }
            *(unsigned*)(sC + (lbase + i) * 272 + n * 2) = pk2(siluf(v0), siluf(v1));
        }
    }
    __syncthreads();
    const int j = w, hd = g * 8 + j;
#pragma unroll 1
    for (int lh = 0; lh < 2; ++lh) {
        f32x16 y[2][2];
#pragma unroll
        for (int a = 0; a < 2; ++a) { y[a][0] = zero16(); y[a][1] = zero16(); }
#pragma unroll 1
        for (int dir = 0; dir < 2; ++dir) {
            const u16* prev = ST + ((((size_t)(b * 16 + hd) * 2 + dir) * 64 + c) * 8192);
            asm volatile("" ::: "memory");
            bf16x8 bfr[2][8];
#pragma unroll
            for (int pblk = 0; pblk < 2; ++pblk)
#pragma unroll
                for (int ks = 0; ks < 8; ++ks) bfr[pblk][ks] = *(const bf16x8*)(prev + (pblk * 32 + l31) * 128 + ks * 16 + hh * 8);
#pragma unroll
            for (int pblk = 0; pblk < 2; ++pblk) {
#pragma unroll
                for (int lb2 = 0; lb2 < 2; ++lb2) {
                    const int lbk = lh * 2 + lb2;
                    f32x16 acc = zero16();
#pragma unroll
                    for (int ks = 0; ks < 8; ++ks) {
                        const bf16x8 a = *(const bf16x8*)(sC + (lbk * 32 + l31) * 272 + (ks * 16 + hh * 8) * 2);
                        acc = MFMA(a, bfr[pblk][ks], acc);
                    }
#pragma unroll
                    for (int grp = 0; grp < 4; ++grp) {
                        const f32x4 e4 = *(const f32x4*)(ea + (dir * 8 + j) * 128 + lbk * 32 + 8 * grp + 4 * hh);
#pragma unroll
                        for (int q = 0; q < 4; ++q) y[lb2][pblk][grp * 4 + q] += e4[q] * acc[grp * 4 + q];
                    }
                }
            }
        }
        const int odd = lane & 1;
#pragma unroll
        for (int lb2 = 0; lb2 < 2; ++lb2) {
            u32x4 ylr[2][2];
#pragma unroll
            for (int pblk = 0; pblk < 2; ++pblk) {
                const u16* yp = YL + (((((size_t)item * 8 + j) * 4 + (lh * 2 + lb2)) * 2 + pblk) * 64 + lane) * 16;
                ylr[pblk][0] = __builtin_nontemporal_load((const u32x4*)yp); ylr[pblk][1] = __builtin_nontemporal_load((const u32x4*)(yp + 8));
            }
#pragma unroll
            for (int i = 0; i < 16; i += 2) {
                const int l0 = (lh * 2 + lb2) * 32 + crow(i, hh);
                float ss0 = 0.f, ss1 = 0.f;
#pragma unroll
                for (int pblk = 0; pblk < 2; ++pblk) {
                    const size_t idx = (size_t)(t0 + l0 + odd) * 1024 + hd * 64 + pblk * 32 + l31 - odd;
                    const unsigned lz = *(const unsigned*)(Z + idx);
                    const unsigned rz = (unsigned)__builtin_amdgcn_mov_dpp((int)lz, 0xB1, 0xF, 0xF, true);
                    const unsigned yw = ylr[pblk][i >> 3][(i >> 1) & 3];
                    const float yl0 = bflo(yw), yl1 = bfhi(yw);
                    const float z0 = odd ? bfhi(rz) : bflo(lz), z1 = odd ? bfhi(lz) : bflo(rz);
                    const float v0 = (y[lb2][pblk][i] + yl0) * siluf(z0), v1 = (y[lb2][pblk][i + 1] + yl1) * siluf(z1);
                    y[lb2][pblk][i] = v0; y[lb2][pblk][i + 1] = v1; ss0 += v0 * v0; ss1 += v1 * v1;
                }
#pragma unroll
                for (int o = 16; o > 0; o >>= 1) { ss0 += __shfl_xor(ss0, o); ss1 += __shfl_xor(ss1, o); }
                if (l31 == 0) { ssq[j * 128 + l0] = ss0; ssq[j * 128 + l0 + 1] = ss1; }
            }
            asm volatile("" ::: "memory");
        }
        __syncthreads();
        if (tid < 64) {
            const int l = lh * 64 + tid;
            float tot = 0.f;
#pragma unroll
            for (int jj = 0; jj < 8; ++jj) tot += ssq[jj * 128 + l];
            rs[l] = rsqrtf(tot * (1.f / 512.f) + 1e-5f);
        }
        __syncthreads();
#pragma unroll
        for (int pblk = 0; pblk < 2; ++pblk) {
            const float gain = p.ssm_norm_g[hd * 64 + pblk * 32 + l31];
#pragma unroll
            for (int lb2 = 0; lb2 < 2; ++lb2)
#pragma unroll
                for (int grp = 0; grp < 4; ++grp) {
                    const int lq = (lh * 2 + lb2) * 32 + 8 * grp + 4 * hh;
                    const f32x4 r4 = *(const f32x4*)(rs + lq);
#pragma unroll
                    for (int q = 0; q < 4; q += 2)
                        *(unsigned*)(Z + (size_t)(t0 + lq + q + odd) * 1024 + hd * 64 + pblk * 32 + l31 - odd) =
                            pair_pack(y[lb2][pblk][grp * 4 + q] * r4[q] * gain, y[lb2][pblk][grp * 4 + q + 1] * r4[q + 1] * gain, odd);
                }
        }
    }
    __syncthreads();
}

DI void attn_item(const Params& p, int b, int h, int qb, float lam, char* lds, int wv) {
    const int tid = otid(wv), lane = tid & 63, w = __builtin_amdgcn_readfirstlane(tid >> 6), l31 = lane & 31, hh = lane >> 5;
    const int r = w & 1, qs = w >> 1;
    u16* Q = (u16*)(p.ws + OFF_Q);
    const u16* Kg = (const u16*)(p.ws + OFF_K);
    const u16* VT = (const u16*)(p.ws + OFF_VT);
    const u16* G = (const u16*)(p.ws + OFF_G);
    float* red = (float*)(lds + 131072);
    const int wq0 = qb * 128 + qs * 32;
    const int tq = wq0 + l31;
    const size_t row = (size_t)b * 8192 + tq;
    bf16x8 qf[4];
#pragma unroll
    for (int ks = 0; ks < 4; ++ks) qf[ks] = *(const bf16x8*)(Q + row * 1024 + h * 128 + r * 64 + ks * 16 + hh * 8);
    const float kn2 = __uint_as_float(((const unsigned*)(p.ws + OFF_KN))[b * 8 + h]);
    float mref;
    {
        float ss = 0.f, dg = 0.f;
#pragma unroll
        for (int ks = 0; ks < 4; ++ks) {
            const bf16x8 kd = *(const bf16x8*)(Kg + ((size_t)(b * 8 + h) * 8192 + tq) * 128 + r * 64 + ks * 16 + hh * 8);
#pragma unroll
            for (int e = 0; e < 8; ++e) { const float v = bf2f((u16)qf[ks][e]); ss += v * v; dg += v * bf2f((u16)kd[e]); }
        }
        ss += __shfl_xor(ss, 32); dg += __shfl_xor(dg, 32);
        mref = 0.5f * (sqrtf(ss * kn2) * 1.001f + dg);
#pragma unroll
        for (int o = 16; o > 0; o >>= 1) { ss = fmaxf(ss, __shfl_xor(ss, o)); dg = fminf(dg, __shfl_xor(dg, o)); }
        if (lane == 0) { red[w] = ss; red[8 + w] = dg; }
    }
    __syncthreads();
    float qn2 = red[0], dmin = red[8];
#pragma unroll
    for (int i = 1; i < 8; ++i) { qn2 = fmaxf(qn2, red[i]); dmin = fminf(dmin, red[8 + i]); }
    const float ms = __builtin_bit_cast(float, __builtin_amdgcn_readfirstlane(__builtin_bit_cast(int, exp2f(-(float)(h + 1)) * LOG2E)));
    const float Dw = fminf((1.001f * sqrtf(qn2 * kn2) - dmin + 40.f) / ms, 1e6f);
    const float q0f = (float)(qb * 128);
    int lo = (int)floorf((q0f - 63.f - Dw) * (1.f / 64.f)) + 1; lo = lo < 0 ? 0 : lo;
    int hi = (int)ceilf((q0f + 127.f + Dw) * (1.f / 64.f)) - 1; hi = hi > 127 ? 127 : hi;
    lo = __builtin_amdgcn_readfirstlane(lo); hi = __builtin_amdgcn_readfirstlane(hi);
    f32x16 O[4];
#pragma unroll
    for (int e = 0; e < 4; ++e) O[e] = zero16();
    float lsum = 0.f;
    const u16* kbase = Kg + (size_t)(b * 8 + h) * 8192 * 128;
    const u16* vbase = VT + (size_t)((b * 8 + h) * 128) * 8192;
    unsigned ksrc[2], vsrc[2];
#pragma unroll
    for (int j = 0; j < 2; ++j) {
        const int piece = w * 2 + j;
        const int key = piece * 4 + (lane >> 4), kpos = lane & 15;
        ksrc[j] = (unsigned)(key * 128 + ((kpos ^ (key & 15)) * 8));
        const int ev = piece * 8 + (lane >> 3), vpos = lane & 7;
        vsrc[j] = (unsigned)(ev * 64 + ((vpos ^ ((ev >> 1) & 7)) * 8));
    }
#define ADMA(kt, buf) do { \
    _Pragma("unroll") for (int j_ = 0; j_ < 2; ++j_) { \
        __builtin_amdgcn_global_load_lds((const unsigned*)(kbase + (size_t)(kt) * 8192 + ksrc[j_]), (LAS unsigned*)(lds + (buf) * 32768 + (w * 2 + j_) * 1024), 16, 0, 0); \
        __builtin_amdgcn_global_load_lds((const unsigned*)(vbase + (size_t)(kt) * 8192 + vsrc[j_]), (LAS unsigned*)(lds + (buf) * 32768 + 16384 + (w * 2 + j_) * 1024), 16, 0, 0); } } while (0)
#define SB __builtin_amdgcn_sched_barrier(0)
    const unsigned kx = (unsigned)(l31 * 256 + (l31 & 15) * 16);
    const unsigned vx = (unsigned)(l31 * 128 + ((l31 >> 1) & 7) * 16);
    f32x16 s[2];
    bf16x8 vf[4];
#define EXP8(KB, H8) do { _Pragma("unroll") for (int i_ = 0; i_ < 8; ++i_) { const float pv_ = __builtin_amdgcn_exp2f(s[KB][(H8) * 8 + i_]); s[KB][(H8) * 8 + i_] = pv_; psum += pv_; } } while (0)
#define PVG(G4) do { const int kb_ = (G4) >> 1, s2_ = (G4) & 1; \
        const bf16x8 pfrag = pack8(s[kb_][8 * s2_], s[kb_][8 * s2_ + 1], s[kb_][8 * s2_ + 2], s[kb_][8 * s2_ + 3], s[kb_][8 * s2_ + 4], s[kb_][8 * s2_ + 5], s[kb_][8 * s2_ + 6], s[kb_][8 * s2_ + 7]); \
        SB; \
        _Pragma("unroll") for (int e = 0; e < 4; ++e) O[e] = MFMA(vf[e], pfrag, O[e]); \
        SB; \
        if ((G4) < 3) { _Pragma("unroll") for (int e = 0; e < 4; ++e) vf[e] = *(const bf16x8*)(vsm + e * 4096 + (vx ^ (unsigned)((((G4) + 1) * 2 + hh) * 16))); } \
        } while (0)
#define TILE_BODY(KT, SLOT) do { \
        const char* ksm = lds + (SLOT) * 32768; const char* vsm = ksm + 16384; \
        const int k0 = (KT) * 64; \
        const float dl2 = (float)(k0 + 4 * hh - tq); \
        bf16x8 kf[2][4]; \
        _Pragma("unroll") for (int kb = 0; kb < 2; ++kb) \
        _Pragma("unroll") for (int ks = 0; ks < 4; ++ks) kf[kb][ks] = *(const bf16x8*)(ksm + kb * 8192 + (kx ^ (unsigned)((r * 8 + ks * 2 + hh) * 16))); \
        SB; \
        if (k0 + 63 < wq0 || k0 > wq0 + 31) { \
            const float sm = (k0 + 63 < wq0) ? ms : -ms; \
            const float tl = sm * dl2 - mref; \
            _Pragma("unroll") for (int kb = 0; kb < 2; ++kb) \
            _Pragma("unroll") for (int i = 0; i < 16; ++i) s[kb][i] = __builtin_fmaf(sm, (float)(kb * 32 + (i & 3) + 8 * (i >> 2)), tl); \
        } else { \
            _Pragma("unroll") for (int kb = 0; kb < 2; ++kb) \
            _Pragma("unroll") for (int i = 0; i < 16; ++i) s[kb][i] = __builtin_fmaf(-ms, fabsf(dl2 + (float)(kb * 32 + (i & 3) + 8 * (i >> 2))), -mref); \
        } \
        SB; \
        _Pragma("unroll") for (int kb = 0; kb < 2; ++kb) \
        _Pragma("unroll") for (int ks = 0; ks < 4; ++ks) s[kb] = MFMA(kf[kb][ks], qf[ks], s[kb]); \
        _Pragma("unroll") for (int e = 0; e < 4; ++e) vf[e] = *(const bf16x8*)(vsm + e * 4096 + (vx ^ (unsigned)(hh * 16))); \
        SB; \
        float psum = 0.f; \
        EXP8(0, 0); EXP8(0, 1); \
        SB; \
        PVG(0); SB; EXP8(1, 0); SB; \
        PVG(1); SB; EXP8(1, 1); SB; \
        PVG(2); SB; \
        PVG(3); SB; \
        lsum += psum; \
    } while (0)
    ADMA(lo, 0);
    if (lo < hi) ADMA(lo + 1, 1);
    asm volatile("s_waitcnt vmcnt(0)" ::: "memory");
    __builtin_amdgcn_s_barrier();
    asm volatile("" ::: "memory");
    if (w >= 4) __builtin_amdgcn_s_setprio(1);
    int sb0 = 0;
    for (int kt = lo; kt <= hi; kt += 2) {
        const int nb0 = sb0 ^ 2;
        if (kt + 2 <= hi) ADMA(kt + 2, nb0);
        if (kt + 3 <= hi) ADMA(kt + 3, nb0 + 1);
        SB;
        TILE_BODY(kt, sb0);
        if (kt + 1 <= hi) TILE_BODY(kt + 1, sb0 + 1);
        asm volatile("s_waitcnt vmcnt(0)" ::: "memory");
        __builtin_amdgcn_s_barrier();
        asm volatile("" ::: "memory");
        sb0 = nb0;
    }
#undef TILE_BODY
#undef EXP8
#undef PVG
    __builtin_amdgcn_s_setprio(0);
    __syncthreads();
#undef ADMA
#undef SB
    lsum += __shfl_xor(lsum, 32);
    const float inv = 1.f / lsum;
    float* X = (float*)lds;
    if (r == 1) {
        const float sc = *(volatile float*)(lds + 131072 + 128) * inv;
#pragma unroll
        for (int e = 0; e < 4; ++e)
#pragma unroll
            for (int i = 0; i < 16; ++i) X[(qs * 64 + e * 16 + i) * 64 + lane] = O[e][i] * sc;
    }
    __syncthreads();
    if (r == 0) {
        float ss = 0.f;
#pragma unroll
        for (int e = 0; e < 4; ++e)
#pragma unroll
            for (int i = 0; i < 16; ++i) { const float o = O[e][i] * inv - X[(qs * 64 + e * 16 + i) * 64 + lane]; O[e][i] = o; ss += o * o; }
        ss += __shfl_xor(ss, 32);
        const float rstd = rsqrtf(ss * (1.f / 128.f) + 1e-5f) * 0.8f;
#pragma unroll
        for (int e = 0; e < 4; ++e)
#pragma unroll
            for (int grp = 0; grp < 4; ++grp) {
                const int ee = e * 32 + 8 * grp + 4 * hh;
                const u32x2 gg = *(const u32x2*)(G + row * 1024 + h * 128 + ee);
                const f32x4 sg = *(const f32x4*)(p.subln_g + ee);
                const float o0 = O[e][grp * 4 + 0] * rstd * sg[0] * siluf(bflo(gg.x));
                const float o1 = O[e][grp * 4 + 1] * rstd * sg[1] * siluf(bfhi(gg.x));
                const float o2 = O[e][grp * 4 + 2] * rstd * sg[2] * siluf(bflo(gg.y));
                const float o3 = O[e][grp * 4 + 3] * rstd * sg[3] * siluf(bfhi(gg.y));
                u32x2 ov; ov.x = pk2(o0, o1); ov.y = pk2(o2, o3);
                *(u32x2*)(Q + row * 1024 + h * 128 + ee) = ov;
            }
    }
    __syncthreads();
}

DI void phase_attn(const Params& p, char* lds, int wv) {
    const int tid = otid(wv), lane = tid & 63;
    const float d1 = wsum(p.lq1[lane] * p.lk1[lane]);
    const float d2 = wsum(p.lq2[lane] * p.lk2[lane]);
    if (tid == 0) *(volatile float*)(lds + 131072 + 128) = expf(d1) - expf(d2) + 0.2f;
    const float lam = 0.f;
    unsigned* ctr = (unsigned*)(p.ws + OFF_CTR);
    volatile int* s_item = (volatile int*)(lds + 131072 + 64);
    for (;;) {
        if (tid == 0) *s_item = (int)atomicAdd(ctr, 1u);
        __syncthreads();
        const int it = *s_item;
        if (it >= 1024) break;
        const int h = 7 - (it >> 7), b = (it >> 6) & 1, qb = it & 63;
        attn_item(p, b, h, qb, lam, lds, wv);
    }
}

DI void phase_gemm2(const Params& p, char* lds, int wv) {
    const pg8::Gemm g{(const u16*)(p.ws + OFF_Z), (const u16*)(p.ws + OFF_Q), (const u16*)(p.ws + OFF_WOT), M_TOK, 1024, 2048, 1024, 16};
    pg8::StaticOrder S; S.init(M_TOK, 1024, gridDim.x, blockIdx.x);
    pg8::gemm_phase<EpiOut, pg8::StaticOrder, true, true>((PG8_LAS unsigned char*)lds, g, S, EpiOut{(u16*)(p.ws + OFF_YL)}, wv);
}

DI void phase_ln_out(const Params& p, int wv) {
    const int tid = otid(wv), lane = tid & 63, w = __builtin_amdgcn_readfirstlane(tid >> 6);
    const int nwaves = gridDim.x * 8;
    f32x4 ge[4], be[4], g2[4], b2[4];
#pragma unroll
    for (int j = 0; j < 4; ++j) {
        ge[j] = *(const f32x4*)(p.ln_emb_g + j * 256 + lane * 4); be[j] = *(const f32x4*)(p.ln_emb_b + j * 256 + lane * 4);
        g2[j] = *(const f32x4*)(p.ln_g + j * 256 + lane * 4); b2[j] = *(const f32x4*)(p.ln_b + j * 256 + lane * 4);
    }
    int row = blockIdx.x * 8 + w;
    f32x4 xv[4]; u32x2 mv[4];
    const u16* MIX = (const u16*)(p.ws + OFF_YL);
    if (row < M_TOK) {
#pragma unroll
        for (int j = 0; j < 4; ++j) { xv[j] = __builtin_nontemporal_load((const f32x4*)(p.x + (size_t)row * 1024 + j * 256 + lane * 4)); mv[j] = __builtin_nontemporal_load((const u32x2*)(MIX + (size_t)row * 1024 + j * 256 + lane * 4)); }
    }
    for (; row < M_TOK; row += nwaves) {
        f32x4 xc[4], mc[4];
#pragma unroll
        for (int j = 0; j < 4; ++j) { xc[j] = xv[j]; mc[j][0] = bflo(mv[j].x); mc[j][1] = bfhi(mv[j].x); mc[j][2] = bflo(mv[j].y); mc[j][3] = bfhi(mv[j].y); }
        const int nrow = row + nwaves;
        if (nrow < M_TOK) {
#pragma unroll
            for (int j = 0; j < 4; ++j) { xv[j] = __builtin_nontemporal_load((const f32x4*)(p.x + (size_t)nrow * 1024 + j * 256 + lane * 4)); mv[j] = __builtin_nontemporal_load((const u32x2*)(MIX + (size_t)nrow * 1024 + j * 256 + lane * 4)); }
        }
        float s = 0.f;
#pragma unroll
        for (int j = 0; j < 4; ++j) s += xc[j][0] + xc[j][1] + xc[j][2] + xc[j][3];
        s = wsum(s);
        const float mean = s * (1.f / 1024.f);
        float q = 0.f;
#pragma unroll
        for (int j = 0; j < 4; ++j)
#pragma unroll
            for (int e = 0; e < 4; ++e) { const float d = xc[j][e] - mean; q += d * d; }
        q = wsum(q);
        const float rstd = rsqrtf(q * (1.f / 1024.f) + 1e-5f);
        float s2 = 0.f;
#pragma unroll
        for (int j = 0; j < 4; ++j)
#pragma unroll
            for (int e = 0; e < 4; ++e) { const float v = ALPHA_DN * ((xc[j][e] - mean) * rstd * ge[j][e] + be[j][e]) + mc[j][e]; mc[j][e] = v; s2 += v; }
        s2 = wsum(s2);
        const float mean2 = s2 * (1.f / 1024.f);
        float q2 = 0.f;
#pragma unroll
        for (int j = 0; j < 4; ++j)
#pragma unroll
            for (int e = 0; e < 4; ++e) { const float d = mc[j][e] - mean2; q2 += d * d; }
        q2 = wsum(q2);
        const float rstd2 = rsqrtf(q2 * (1.f / 1024.f) + 1e-5f);
#pragma unroll
        for (int j = 0; j < 4; ++j) {
            f32x4 h;
#pragma unroll
            for (int e = 0; e < 4; ++e) h[e] = (mc[j][e] - mean2) * rstd2 * g2[j][e] + b2[j][e];
            __builtin_nontemporal_store(h, (f32x4*)(p.out + (size_t)row * 1024 + j * 256 + lane * 4));
        }
    }
}

__global__ void __launch_bounds__(512) hybrid_fwd(Params p) {
    extern __shared__ __attribute__((aligned(16))) char lds[];
    cg::grid_group grid = cg::this_grid();
    const int wv = __builtin_amdgcn_readfirstlane((int)(threadIdx.x >> 6));
#define GBAR() do { XcdBarrier b_; b_.bar = (unsigned*)(p.ws + OFF_BAR); b_.x = xb_xcc_id(); b_.st = (volatile LAS unsigned*)(lds + LDS_BYTES - 16); xcd_barrier(b_, otid(wv) == 0); } while (0)
    if (threadIdx.x == 0) { volatile LAS unsigned* xst = (volatile LAS unsigned*)(lds + LDS_BYTES - 16); xst[0] = 0u; xst[1] = 0u; }
    phase_prep(p, lds, wv);
    grid.sync();
    (void)xcd_barrier_post((unsigned*)(p.ws + OFF_BAR), (volatile LAS unsigned*)(lds + LDS_BYTES - 16), otid(wv) == 0);
    phase_gemm1(p, lds, wv);
    GBAR();
    for (int it = blockIdx.x; it < 256; it += gridDim.x) ssdA_item(p, it, lds, wv);
    GBAR();
    phase_scan(p, wv);
    GBAR();
    for (int it = blockIdx.x; it < 256; it += gridDim.x) ssdC_item(p, it, lds, wv);
    phase_attn(p, lds, wv);
    GBAR();
    phase_gemm2(p, lds, wv);
    GBAR();
    phase_ln_out(p, wv);
#undef GBAR
}

extern "C" void kernel_launch(void* const* d_in, const int* in_sizes, int n_in, void* d_out, int out_size, void* d_ws, size_t ws_size,
                              hipStream_t stream) {
    static int grid_blocks = 0;
    if (!grid_blocks) {
        int dev = 0, cus = 0, per_cu = 0;
        hipGetDevice(&dev);
        hipDeviceGetAttribute(&cus, hipDeviceAttributeMultiprocessorCount, dev);
        hipFuncSetAttribute((const void*)hybrid_fwd, hipFuncAttributeMaxDynamicSharedMemorySize, LDS_BYTES);
        hipOccupancyMaxActiveBlocksPerMultiprocessor(&per_cu, hybrid_fwd, 512, LDS_BYTES);
        if (per_cu > 1) per_cu = 1;
        grid_blocks = cus * per_cu;
        if (grid_blocks <= 0) grid_blocks = 256;
    }
    if (ws_size < WS_NEED) { fprintf(stderr, "workspace too small: %zu < %zu\n", ws_size, (size_t)WS_NEED); return; }
    Params p{};
    const float** f = (const float**)&p;
    for (int i = 0; i < 20; ++i) f[i] = (const float*)d_in[i];
    p.out = (float*)d_out;
    p.ws = (char*)d_ws;
    void* args[] = {&p};
    hipError_t e = hipLaunchCooperativeKernel((const void*)hybrid_fwd, dim3(grid_blocks), dim3(512), args, LDS_BYTES, stream);
    if (e != hipSuccess) fprintf(stderr, "cooperative launch failed: %s (grid %d)\n", hipGetErrorString(e), grid_blocks);
}
```

```cpp
#include <hip/hip_runtime.h>
#include <hip/hip_cooperative_groups.h>
#include <cstdio>
#include <cstdint>
namespace cg = cooperative_groups;

#define DI __device__ __forceinline__
typedef unsigned short u16;
typedef short bf16x8 __attribute__((ext_vector_type(8)));
typedef short bf16x4 __attribute__((ext_vector_type(4)));
typedef float f32x16 __attribute__((ext_vector_type(16)));
typedef float f32x4 __attribute__((ext_vector_type(4)));
typedef float f32x2 __attribute__((ext_vector_type(2)));
typedef __bf16 bf2_t __attribute__((ext_vector_type(2)));
typedef unsigned u32x4 __attribute__((ext_vector_type(4)));
typedef unsigned u32x2 __attribute__((ext_vector_type(2)));
#define MFMA(a, b, c) __builtin_amdgcn_mfma_f32_32x32x16_bf16((a), (b), (c), 0, 0, 0)

constexpr int M_TOK = 16384;
constexpr float LOG2E = 1.4426950408889634f;
constexpr float ALPHA_DN = 1.189207115002721f;

constexpr size_t SZ_ACT = (size_t)M_TOK * 1024 * 2;
constexpr size_t OFF_Z = 0;
constexpr size_t OFF_XBC = OFF_Z + SZ_ACT;
constexpr size_t OFF_Q = OFF_XBC + (size_t)M_TOK * 1536 * 2;
constexpr size_t OFF_K = OFF_Q + SZ_ACT;
constexpr size_t OFF_VT = OFF_K + SZ_ACT;
constexpr size_t OFF_G = OFF_VT + SZ_ACT;
constexpr size_t OFF_YL = OFF_G + SZ_ACT;
constexpr size_t OFF_DT = OFF_YL + SZ_ACT;
constexpr size_t OFF_EA = OFF_DT + (size_t)M_TOK * 32 * 4;
constexpr size_t OFF_WOT = OFF_EA + (size_t)M_TOK * 32 * 4;
constexpr size_t OFF_STATS = OFF_WOT + (size_t)1024 * 2048 * 2;
constexpr size_t OFF_DEC = OFF_STATS + (size_t)M_TOK * 2 * 4;
constexpr size_t OFF_KN = OFF_DEC + (size_t)2 * 16 * 2 * 64 * 4;
constexpr size_t OFF_CTR = OFF_KN + 256;
constexpr size_t OFF_BAR = OFF_CTR + 256;
constexpr size_t WS_NEED = OFF_BAR + 16384;
constexpr int LDS_BYTES = 153616;

struct Params {
    const float *x, *ln_emb_g, *ln_emb_b, *w_in, *conv_w, *conv_b, *A_log_f, *A_log_b, *dt_bias_f, *dt_bias_b, *D,
        *ssm_norm_g, *lq1, *lk1, *lq2, *lk2, *subln_g, *w_out, *ln_g, *ln_b;
    float* out;
    char* ws;
};

DI unsigned pk2(float lo, float hi) { f32x2 v = {lo, hi}; bf2_t b = __builtin_convertvector(v, bf2_t); return __builtin_bit_cast(unsigned, b); }
DI u16 tobf(float x) { return (u16)(pk2(x, 0.f) & 0xffffu); }
DI float bf2f(u16 v) { return __uint_as_float(((unsigned)v) << 16); }
DI float bflo(unsigned u) { return __uint_as_float(u << 16); }
DI float bfhi(unsigned u) { return __uint_as_float(u & 0xffff0000u); }
DI float wsum(float v) {
#pragma unroll
    for (int o = 32; o > 0; o >>= 1) v += __shfl_xor(v, o);
    return v;
}
DI float siluf(float v) { return v / (1.f + __expf(-v)); }
DI float softplusf(float x) { return x > 20.f ? x : log1pf(expf(x)); }
DI int otid(int wv) { int t = wv * 64 + (int)__builtin_amdgcn_mbcnt_hi(~0u, __builtin_amdgcn_mbcnt_lo(~0u, 0u)); asm volatile("" : "+v"(t)); return t; }
DI int crow(int i, int hh) { return (i & 3) + 8 * (i >> 2) + 4 * hh; }
DI bf16x8 pack8(float a0, float a1, float a2, float a3, float a4, float a5, float a6, float a7) {
    u32x4 p; p.x = pk2(a0, a1); p.y = pk2(a2, a3); p.z = pk2(a4, a5); p.w = pk2(a6, a7);
    return __builtin_bit_cast(bf16x8, p);
}
DI f32x16 zero16() { f32x16 z;
#pragma unroll
    for (int i = 0; i < 16; ++i) z[i] = 0.f;
    return z; }

#define XB_TMO      128
#define XB_XCNT(j)  (256  + 64 * (j))
#define XB_XSUB(j)  (1280 + 64 * (j))
#define XB_XGEN(j)  (2304 + 64 * (j))
#define XB_TOP      3328
#define XB_TOPGEN   3392
#define XCD_BAR_WORDS 3456
#define XB_SPIN_CAP (1u << 18)
#define LAS __attribute__((address_space(3)))

__device__ __forceinline__ unsigned xb_ld(unsigned* p)              { return __hip_atomic_load(p, __ATOMIC_RELAXED, __HIP_MEMORY_SCOPE_AGENT); }
__device__ __forceinline__ unsigned xb_add(unsigned* p, unsigned v) { return __hip_atomic_fetch_add(p, v, __ATOMIC_RELAXED, __HIP_MEMORY_SCOPE_AGENT); }
__device__ __forceinline__ unsigned xb_xcc_id() { return (unsigned)__builtin_amdgcn_s_getreg((3 << 11) | 20) & 0xFu; }
#define XB_SPIN(cond, bar) do { unsigned _sp = 0; while (cond) { __builtin_amdgcn_s_sleep(1); \
    if ((++_sp & 255u) == 0u) { if (xb_ld(&(bar)[XB_TMO])) break; if (_sp > XB_SPIN_CAP) { atomicAdd(&(bar)[XB_TMO], 1u); break; } } } } while (0)

struct XcdBarrier {
    unsigned* bar; unsigned x;
    volatile LAS unsigned* st;
};

__device__ __forceinline__ XcdBarrier xcd_barrier_post(unsigned* bar, volatile LAS unsigned* st, bool leader) {
    XcdBarrier b; b.bar = bar; b.x = xb_xcc_id(); b.st = st;
    if (leader) (void)xb_add(&bar[XB_XCNT(b.x)], 1u);
    return b;
}
__device__ __forceinline__ void xcd_barrier_complete(unsigned* bar, unsigned x, unsigned& nloc, unsigned& nx) {
    const unsigned G = gridDim.x * gridDim.y * gridDim.z;
    unsigned sum, cnt, mine, sp = 0u;
    for (;;) {
        sum = 0u; cnt = 0u; mine = 0u;
#pragma unroll
        for (unsigned j = 0; j < 16; ++j) { const unsigned c = xb_ld(&bar[XB_XCNT(j)]); sum += c; cnt += (c > 0u) ? 1u : 0u; mine = (j == x) ? c : mine; }
        if (sum == G) break;
        __builtin_amdgcn_s_sleep(1);
        if ((++sp & 255u) == 0u) { if (xb_ld(&bar[XB_TMO])) break; if (sp > XB_SPIN_CAP) { atomicAdd(&bar[XB_TMO], 1u); break; } }
    }
    nloc = mine > 0u ? mine : 1u; nx = cnt > 0u ? cnt : 1u;
}

__device__ __forceinline__ void xcd_barrier(const XcdBarrier& b, bool leader) {
    asm volatile("s_waitcnt vmcnt(0)" ::: "memory");
    __syncthreads();
    if (leader) {
        unsigned* bar = b.bar;
        __builtin_amdgcn_s_waitcnt(0);
        unsigned nloc = b.st[0], nx = b.st[1];
        if (nloc == 0u) { xcd_barrier_complete(bar, b.x, nloc, nx); b.st[0] = nloc; b.st[1] = nx; }
        const unsigned old = xb_add(&bar[XB_XSUB(b.x)], 1u);
        const unsigned gen = old / nloc;
        if (old + 1u == (gen + 1u) * nloc) {
            __builtin_amdgcn_fence(__ATOMIC_RELEASE, "agent");
            asm volatile("s_waitcnt vmcnt(0)" ::: "memory");
            const unsigned og = xb_add(&bar[XB_TOP], 1u);
            const unsigned tg = og / nx;
            if (og + 1u == (tg + 1u) * nx) xb_add(&bar[XB_TOPGEN], 1u);
            else XB_SPIN(xb_ld(&bar[XB_TOPGEN]) == tg, bar);
            __builtin_amdgcn_fence(__ATOMIC_ACQUIRE, "agent");
            xb_add(&bar[XB_XGEN(b.x)], 1u);
            asm volatile("s_waitcnt vmcnt(0)" ::: "memory");
        } else {
            XB_SPIN(xb_ld(&bar[XB_XGEN(b.x)]) == gen, bar);
            __builtin_amdgcn_fence(__ATOMIC_ACQUIRE, "agent");
            asm volatile("s_waitcnt vmcnt(0)" ::: "memory");
        }
    }
    __syncthreads();
}


DI void phase_prep(const Params& p, char* lds, int wv) {
    const int tid = otid(wv), lane = tid & 63, w = __builtin_amdgcn_readfirstlane(tid >> 6);
    u16* HB = (u16*)p.out;
    u16* WIT = HB + (size_t)M_TOK * 1024;
    u16* WOT = (u16*)(p.ws + OFF_WOT);
    const int nwaves = gridDim.x * 8;
    {
        f32x4 g4[4], b4[4], nx[4];
#pragma unroll
        for (int j = 0; j < 4; ++j) { g4[j] = *(const f32x4*)(p.ln_emb_g + j * 256 + lane * 4); b4[j] = *(const f32x4*)(p.ln_emb_b + j * 256 + lane * 4); }
        int row = blockIdx.x * 8 + w;
        if (row < M_TOK) {
#pragma unroll
            for (int j = 0; j < 4; ++j) nx[j] = __builtin_nontemporal_load((const f32x4*)(p.x + (size_t)row * 1024 + j * 256 + lane * 4));
        }
        for (; row < M_TOK; row += nwaves) {
            f32x4 v[4];
#pragma unroll
            for (int j = 0; j < 4; ++j) v[j] = nx[j];
            if (row + nwaves < M_TOK) {
#pragma unroll
                for (int j = 0; j < 4; ++j) nx[j] = __builtin_nontemporal_load((const f32x4*)(p.x + (size_t)(row + nwaves) * 1024 + j * 256 + lane * 4));
            }
            float s = 0.f;
#pragma unroll
            for (int j = 0; j < 4; ++j) s += v[j][0] + v[j][1] + v[j][2] + v[j][3];
            s = wsum(s);
            const float mean = s * (1.f / 1024.f);
            float q = 0.f;
#pragma unroll
            for (int j = 0; j < 4; ++j)
#pragma unroll
                for (int e = 0; e < 4; ++e) { float d = v[j][e] - mean; q += d * d; }
            q = wsum(q);
            const float rstd = rsqrtf(q * (1.f / 1024.f) + 1e-5f);
#pragma unroll
            for (int j = 0; j < 4; ++j) {
                f32x4 h;
#pragma unroll
                for (int e = 0; e < 4; ++e) h[e] = (v[j][e] - mean) * rstd * g4[j][e] + b4[j][e];
                u32x2 o; o.x = pk2(h[0], h[1]); o.y = pk2(h[2], h[3]);
                *(u32x2*)(HB + (size_t)row * 1024 + j * 256 + lane * 4) = o;
            }
        }
    }
    u16* T = (u16*)lds;
    const int n_tiles_in = 105 * 16, n_tiles_out = 16 * 32;
    for (int t = blockIdx.x; t < n_tiles_in + n_tiles_out; t += gridDim.x) {
        const float* W; int ldw, nsrc, k0, n0, ldd; u16* dst; bool isin = t < n_tiles_in;
        if (isin) { W = p.w_in; ldw = 6688; nsrc = 6688; k0 = (t & 15) * 64; n0 = (t >> 4) * 64; dst = WIT; ldd = 1024; }
        else { int u = t - n_tiles_in; W = p.w_out; ldw = 1024; nsrc = 1024; k0 = (u & 31) * 64; n0 = (u >> 5) * 64; dst = WOT; ldd = 2048; }
#pragma unroll
        for (int i = 0; i < 2; ++i) {
            const int e = tid + 512 * i, k = e >> 4, n4 = (e & 15) * 4;
            f32x4 v = {0.f, 0.f, 0.f, 0.f};
            if (n0 + n4 < nsrc) v = __builtin_nontemporal_load((const f32x4*)(W + (size_t)(k0 + k) * ldw + n0 + n4));
#pragma unroll
            for (int q = 0; q < 4; ++q) T[(n4 + q) * 66 + k] = tobf(v[q]);
        }
        __syncthreads();
        {
            const int n = tid >> 3, kc = (tid & 7) * 8, ns = n0 + n;
            if (ns < nsrc) {
                int nd = ns;
                if (isin) nd = (ns < 2560) ? ns : (ns < 2592) ? (ns + 3072) : (ns < 4640) ? (ns - 32) : (ns < 5664) ? (ns + 1248) : (ns - 1056);
                const unsigned* tp = (const unsigned*)(T + n * 66 + kc);
                u32x4 o; o.x = tp[0]; o.y = tp[1]; o.z = tp[2]; o.w = tp[3];
                *(u32x4*)(dst + (size_t)nd * ldd + k0 + kc) = o;
            }
        }
        __syncthreads();
    }
    if (blockIdx.x == 0) { if (tid < 128) ((unsigned*)(p.ws + OFF_KN))[tid] = 0u;
        for (int e = tid; e < 4096; e += 512) ((unsigned*)(p.ws + OFF_BAR))[e] = 0u; }
    for (int e = blockIdx.x * 512 + tid; e < 224 * 512; e += gridDim.x * 512) ((unsigned*)(WIT + (size_t)5664 * 1024))[e] = 0u;
}

namespace pg8 {
#define PG8_LAS __attribute__((address_space(3)))
typedef unsigned short bf16_t;
typedef short bf16x8 __attribute__((ext_vector_type(8)));
typedef float f32x4 __attribute__((ext_vector_type(4)));
typedef unsigned u32x4 __attribute__((ext_vector_type(4)));
constexpr int BM = 256, BK = 64, HALF = 128, HTB = HALF * BK * 2  , STAGE_BYTES = 8 * HTB, NXCD = 8, WGM = 8;

__host__ __device__ __forceinline__ int lds_byte(int r, int c) { const int st = (r >> 4) * 2 + (c >> 5), rr = r & 15, cc = c & 31, ob = rr * 64 + cc * 2; return st * 1024 + (ob ^ (((ob >> 9) & 1) << 5)); }
__host__ __device__ __forceinline__ void stage_rc(int b, int& R, int& C) { const int st = b / 1024, sb = b % 1024, swz = sb ^ (((sb >> 9) & 1) << 5); R = (st >> 1) * 16 + swz / 64; C = (st & 1) * 32 + (swz % 64) / 2; }
__host__ __device__ __forceinline__ int perm32(int rho) { const int n = rho >> 4, i = rho & 15; return 8 * (i >> 2) + 4 * n + (i & 3); }

struct Unit { int pm, pn; };
struct Gemm { const bf16_t* A; const bf16_t* A1; const bf16_t* Bt; int M, N, K, lda, ksplit; };

struct StaticOrder {
    int nM, nN, nwg, G, c;
    __host__ __device__ void init(int M, int N, int G_, int c_) { nM = M / BM; nN = N / BM; nwg = nM * nN; G = G_; c = c_; }
    __host__ __device__ bool next(int i, Unit& u) const {
        const long L = (long)i * G + c; if (L >= nwg) return false;
        int wgid = (int)L; { const int q = nwg / NXCD, r = nwg % NXCD, xcd = wgid % NXCD, off = wgid / NXCD; wgid = (xcd < r ? xcd * (q + 1) : r * (q + 1) + (xcd - r) * q) + off; }
        const int nig = WGM * nN, gid = wgid / nig, fm = gid * WGM, gsz = (nM - fm) < WGM ? (nM - fm) : WGM;
        u.pm = fm + ((wgid % nig) % gsz); u.pn = (wgid % nig) / gsz; return true;
    }
    __device__ __forceinline__ void a_ready(const Unit&) const {}
    __device__ __forceinline__ void done(const Unit&) const {}
};
template <class Epi, class Sched, bool ALIGN_EPI = false, bool SP2 = false>
__device__ __forceinline__ void gemm_phase(PG8_LAS unsigned char* lds, const Gemm g, const Sched& S, const Epi& E, int wv) {
    const int tid = otid(wv), wid = __builtin_amdgcn_readfirstlane(tid >> 6), lane = tid & 63, wr = wid >> 2, wc = wid & 3, fr = lane & 15, fq = lane >> 4;
    const int K = g.K, nt = K / BK;
    unsigned voffA[2], voffB[2];
#pragma unroll
    for (int i = 0; i < 2; ++i) { int R, C; stage_rc(tid * 16 + i * 8192, R, C); const int Rb = Epi::PERM ? ((R & ~31) + perm32(R & 31)) : R;
        voffA[i] = (unsigned)(R * g.lda + C) * 2u; voffB[i] = (unsigned)(Rb * K + C) * 2u; }
    const size_t kstep = (size_t)(BK * 2);
    const size_t hstep = (size_t)HALF * K * 2;
    const size_t tstep = 2 * hstep;
    const size_t hstepA = (size_t)HALF * g.lda * 2, tstepA = 2 * hstepA;
    const int ksp = g.ksplit;
#define PG8_AP(b0, b1, t_) (((t_) < ksp) ? ((b0) + (size_t)(t_) * kstep) : ((b1) + (size_t)((t_) - ksp) * kstep))
    const unsigned ldsw = (unsigned)wid * 1024u;
    const int aoff = lds_byte(wr * 64 + fr, fq * 8), boff = lds_byte(wc * 32 + fr, fq * 8);
#define PG8_SA(b, h) (((b) * 2 + (h)) * HTB)
#define PG8_SB(b, h) ((4 + (b) * 2 + (h)) * HTB)
#define PG8_STAGE(bufoff, gbase, voff) do { _Pragma("unroll") for (int _i = 0; _i < 2; ++_i) \
        __builtin_amdgcn_global_load_lds((const unsigned*)((const char*)(gbase) + (voff)[_i]), (PG8_LAS unsigned*)(lds + (bufoff) + ldsw + _i * 8192), 16, 0, 0); } while (0)
#define PG8_LDA(dst, b, h) do { _Pragma("unroll") for (int m = 0; m < 4; ++m) _Pragma("unroll") for (int k = 0; k < 2; ++k) dst[m][k] = *(const PG8_LAS bf16x8*)(lds + PG8_SA(b, h) + aoff + m * 2048 + k * 1024); } while (0)
#define PG8_LDB(dst, b, h) do { _Pragma("unroll") for (int n = 0; n < 2; ++n) _Pragma("unroll") for (int k = 0; k < 2; ++k) dst[n][k] = *(const PG8_LAS bf16x8*)(lds + PG8_SB(b, h) + boff + n * 2048 + k * 1024); } while (0)
#define PG8_MMA(ai, bj, At, Bt) do { __builtin_amdgcn_s_setprio(1); _Pragma("unroll") for (int m = 0; m < 4; ++m) _Pragma("unroll") for (int n = 0; n < 2; ++n) _Pragma("unroll") for (int k = 0; k < 2; ++k) \
        acc[ai][bj][m][n] = __builtin_amdgcn_mfma_f32_16x16x32_bf16(Bt[n][k], At[m][k], acc[ai][bj][m][n], 0, 0, 0); __builtin_amdgcn_s_setprio(0); } while (0)
#define PG8_WAIT_V(n) asm volatile("s_waitcnt vmcnt(" #n ")" ::: "memory")
#define PG8_WAIT_L(n) asm volatile("s_waitcnt lgkmcnt(" #n ")" ::: "memory")
#define PG8_BAR __builtin_amdgcn_s_barrier()
#define PG8_SCHED __builtin_amdgcn_sched_barrier(0)
    Unit cur, nxt; int ui = 0;
    if (!S.next(0, cur)) return;
    f32x4 acc[2][2][4][2];
#pragma unroll
    for (int a = 0; a < 2; ++a)
#pragma unroll
        for (int b = 0; b < 2; ++b)
#pragma unroll
            for (int m = 0; m < 4; ++m)
#pragma unroll
                for (int n = 0; n < 2; ++n) acc[a][b][m][n] = (f32x4){0.f, 0.f, 0.f, 0.f};
    bf16x8 At[4][2], B0[2][2], B1[2][2];
    const char* cA = (const char*)g.A + (size_t)cur.pm * tstepA; const char* cA1 = (const char*)g.A1 + (size_t)cur.pm * tstepA; const char* cB = (const char*)g.Bt + (size_t)cur.pn * tstep;
    S.a_ready(cur);
    if constexpr (SP2) {
        PG8_STAGE(PG8_SB(0, 0), cB, voffB); PG8_STAGE(PG8_SB(0, 1), cB + hstep, voffB); PG8_STAGE(PG8_SA(0, 0), cA, voffA); PG8_STAGE(PG8_SA(0, 1), cA + hstepA, voffA);
        if (wr == 1) PG8_BAR;
        PG8_WAIT_V(2); PG8_BAR;
        PG8_STAGE(PG8_SB(1, 0), cB + kstep, voffB); PG8_STAGE(PG8_SA(1, 0), PG8_AP(cA, cA1, 1), voffA); PG8_STAGE(PG8_SB(1, 1), cB + hstep + kstep, voffB);
        PG8_WAIT_V(6); PG8_BAR;
    } else {
        PG8_STAGE(PG8_SB(0, 0), cB, voffB); PG8_STAGE(PG8_SA(0, 0), cA, voffA); PG8_STAGE(PG8_SB(0, 1), cB + hstep, voffB); PG8_STAGE(PG8_SA(0, 1), cA + hstepA, voffA);
        if (wr == 1) PG8_BAR;
        PG8_WAIT_V(4); PG8_BAR;
        PG8_STAGE(PG8_SB(1, 0), cB + kstep, voffB); PG8_STAGE(PG8_SA(1, 0), PG8_AP(cA, cA1, 1), voffA); PG8_STAGE(PG8_SB(1, 1), cB + hstep + kstep, voffB);
        PG8_WAIT_V(6); PG8_BAR;
    }
    for (;;) {
        const bool has_next = S.next(ui + 1, nxt);
        const char* nA = has_next ? (const char*)g.A + (size_t)nxt.pm * tstepA : cA; const char* nA1 = has_next ? (const char*)g.A1 + (size_t)nxt.pm * tstepA : cA1; const char* nB = has_next ? (const char*)g.Bt + (size_t)nxt.pn * tstep : cB;
        for (int t = 0; t < nt; t += 2) {
            const bool last = (t == nt - 2);
            const char* a1 = PG8_AP(cA, cA1, t + 1);
            const char* a2 = last ? nA : PG8_AP(cA, cA1, t + 2); const char* b2 = last ? nB : cB + (size_t)(t + 2) * kstep;
            const char* a3 = a2 + kstep; const char* b3 = b2 + kstep;
            if (last && has_next) S.a_ready(nxt);
            if constexpr (SP2) {
            PG8_LDB(B0, 0, 0); PG8_LDB(B1, 0, 1); PG8_SCHED; PG8_LDA(At, 0, 0); PG8_STAGE(PG8_SA(1, 1), a1 + hstepA, voffA);
            PG8_WAIT_V(8); PG8_WAIT_L(0); PG8_BAR; PG8_MMA(0, 0, At, B0); PG8_MMA(0, 1, At, B1); PG8_BAR; PG8_SCHED;
            PG8_LDA(At, 0, 1); PG8_STAGE(PG8_SB(0, 0), b2, voffB); PG8_STAGE(PG8_SB(0, 1), b2 + hstep, voffB); PG8_STAGE(PG8_SA(0, 0), a2, voffA);
            PG8_WAIT_V(8); PG8_WAIT_L(0); PG8_BAR; PG8_MMA(1, 0, At, B0); PG8_MMA(1, 1, At, B1); PG8_BAR; PG8_SCHED;
            PG8_LDB(B0, 1, 0); PG8_LDB(B1, 1, 1); PG8_SCHED; PG8_LDA(At, 1, 0); PG8_STAGE(PG8_SA(0, 1), a2 + hstepA, voffA);
            PG8_WAIT_V(8); PG8_WAIT_L(0); PG8_BAR; PG8_MMA(0, 0, At, B0); PG8_MMA(0, 1, At, B1); PG8_BAR; PG8_SCHED;
            PG8_LDA(At, 1, 1); PG8_STAGE(PG8_SB(1, 0), b3, voffB); PG8_STAGE(PG8_SB(1, 1), b3 + hstep, voffB); PG8_STAGE(PG8_SA(1, 0), a3, voffA);
            PG8_WAIT_V(8); PG8_WAIT_L(0); PG8_BAR; PG8_MMA(1, 0, At, B0); PG8_MMA(1, 1, At, B1); PG8_BAR; PG8_SCHED;
            } else {
            PG8_LDB(B0, 0, 0); PG8_SCHED; PG8_LDA(At, 0, 0); PG8_STAGE(PG8_SA(1, 1), a1 + hstepA, voffA);
            PG8_WAIT_L(8); PG8_BAR; PG8_WAIT_L(0); PG8_MMA(0, 0, At, B0); PG8_BAR; PG8_SCHED;
            PG8_LDB(B1, 0, 1); PG8_STAGE(PG8_SB(0, 0), b2, voffB);
            PG8_BAR; PG8_WAIT_L(0); PG8_MMA(0, 1, At, B1); PG8_BAR;
            PG8_LDA(At, 0, 1); PG8_STAGE(PG8_SA(0, 0), a2, voffA);
            PG8_BAR; PG8_WAIT_L(0); PG8_MMA(1, 0, At, B0); PG8_BAR; PG8_SCHED;
            PG8_STAGE(PG8_SB(0, 1), b2 + hstep, voffB);
            PG8_WAIT_V(6); PG8_BAR; PG8_MMA(1, 1, At, B1); PG8_BAR;
            PG8_LDB(B0, 1, 0); PG8_SCHED; PG8_LDA(At, 1, 0); PG8_STAGE(PG8_SA(0, 1), a2 + hstepA, voffA);
            PG8_WAIT_L(8); PG8_BAR; PG8_WAIT_L(0); PG8_MMA(0, 0, At, B0); PG8_BAR; PG8_SCHED;
            PG8_LDB(B1, 1, 1); PG8_STAGE(PG8_SB(1, 0), b3, voffB);
            PG8_BAR; PG8_WAIT_L(0); PG8_MMA(0, 1, At, B1); PG8_BAR;
            PG8_LDA(At, 1, 1); PG8_STAGE(PG8_SA(1, 0), a3, voffA);
            PG8_BAR; PG8_WAIT_L(0); PG8_MMA(1, 0, At, B0); PG8_BAR; PG8_SCHED;
            PG8_STAGE(PG8_SB(1, 1), b3 + hstep, voffB);
            PG8_WAIT_V(6); PG8_BAR; PG8_MMA(1, 1, At, B1); PG8_BAR;
            }
        }
        if constexpr (ALIGN_EPI) { if (wr == 0) PG8_BAR; }
        if constexpr (!Epi::AFTER_DRAIN) { E(acc, cur, wr, wc, fr, fq); S.done(cur); }
        if (!has_next) break;
#pragma unroll
        for (int a = 0; a < 2; ++a)
#pragma unroll
            for (int b = 0; b < 2; ++b)
#pragma unroll
                for (int m = 0; m < 4; ++m)
#pragma unroll
                    for (int n = 0; n < 2; ++n) acc[a][b][m][n] = (f32x4){0.f, 0.f, 0.f, 0.f};
        cur = nxt; cA = nA; cA1 = nA1; cB = nB; ++ui;
        if constexpr (ALIGN_EPI) { if (wr == 1) PG8_BAR; }
    }
    PG8_WAIT_V(0);
    if constexpr (!ALIGN_EPI) { if (wr == 0) PG8_BAR; }
    PG8_BAR;
    if constexpr (Epi::AFTER_DRAIN) { E.fused(acc, cur, wr, wc, fr, fq, lds, wid, lane); S.done(cur); }
#undef PG8_AP
#undef PG8_SA
#undef PG8_SB
#undef PG8_STAGE
#undef PG8_LDA
#undef PG8_LDB
#undef PG8_MMA
#undef PG8_WAIT_V
#undef PG8_WAIT_L
#undef PG8_BAR
#undef PG8_SCHED
}
}


struct EpiProj {
    static constexpr bool PERM = true, AFTER_DRAIN = false;
    char* ws;
    DI void operator()(const pg8::f32x4 (&acc)[2][2][4][2], const pg8::Unit& u, int wr, int wc, int fr, int fq) const {
        const int pn = u.pn, row0 = u.pm * 256 + wr * 64 + fr;
        if (pn < 22) {
            u16* dst; int ld, cb; float sc = 1.f; const bool isk = (pn >= 14 && pn < 18);
            if (pn < 4) { dst = (u16*)(ws + OFF_Z); ld = 1024; cb = pn * 256; }
            else if (pn < 10) { dst = (u16*)(ws + OFF_XBC); ld = 1536; cb = (pn - 4) * 256; }
            else if (pn < 14) { dst = (u16*)(ws + OFF_Q); ld = 1024; cb = (pn - 10) * 256; sc = 0.125f * LOG2E; }
            else if (pn < 18) { dst = (u16*)(ws + OFF_K); ld = 128; cb = 0; }
            else { dst = (u16*)(ws + OFF_G); ld = 1024; cb = (pn - 18) * 256; }
#pragma unroll
            for (int ai = 0; ai < 2; ++ai)
#pragma unroll
                for (int m = 0; m < 4; ++m) {
                    const int r = row0 + ai * 128 + m * 16;
#pragma unroll
                    for (int bj = 0; bj < 2; ++bj) {
                        const size_t rowaddr = isk ? ((size_t)((r >> 13) * 8 + (pn - 14) * 2 + bj) * 8192 + (r & 8191)) : (size_t)r;
                        const int col = isk ? (wc * 32 + 8 * fq) : (cb + bj * 128 + wc * 32 + 8 * fq);
                        const pg8::f32x4 v0 = acc[ai][bj][m][0], v1 = acc[ai][bj][m][1];
                        u32x4 wv4; wv4.x = pk2(v0[0] * sc, v0[1] * sc); wv4.y = pk2(v0[2] * sc, v0[3] * sc); wv4.z = pk2(v1[0] * sc, v1[1] * sc); wv4.w = pk2(v1[2] * sc, v1[3] * sc);
                        *(u32x4*)(dst + rowaddr * ld + col) = wv4;
                    }
                }
        } else if (wc == 0) {
            float* DT = (float*)(ws + OFF_DT);
#pragma unroll
            for (int ai = 0; ai < 2; ++ai)
#pragma unroll
                for (int m = 0; m < 4; ++m) {
                    const int r = row0 + ai * 128 + m * 16;
                    *(f32x4*)(DT + (size_t)r * 32 + 8 * fq) = acc[ai][0][m][0];
                    *(f32x4*)(DT + (size_t)r * 32 + 8 * fq + 4) = acc[ai][0][m][1];
                }
        }
    }
};
struct EpiVT {
    static constexpr bool PERM = true, AFTER_DRAIN = false;
    char* ws;
    DI void operator()(const pg8::f32x4 (&acc)[2][2][4][2], const pg8::Unit& u, int wr, int wc, int fr, int fq) const {
        u16* VT = (u16*)(ws + OFF_VT);
#pragma unroll
        for (int ai = 0; ai < 2; ++ai)
#pragma unroll
            for (int m = 0; m < 4; ++m) {
                const int eg = u.pm * 256 + ai * 128 + wr * 64 + m * 16 + fr, head = eg >> 7, e = eg & 127;
#pragma unroll
                for (int bj = 0; bj < 2; ++bj) {
                    const int tok = u.pn * 256 + bj * 128 + wc * 32 + 8 * fq, b = tok >> 13, t = tok & 8191;
                    const pg8::f32x4 v0 = acc[ai][bj][m][0], v1 = acc[ai][bj][m][1];
                    u32x4 wv4; wv4.x = pk2(v0[0], v0[1]); wv4.y = pk2(v0[2], v0[3]); wv4.z = pk2(v1[0], v1[1]); wv4.w = pk2(v1[2], v1[3]);
                    u16* vp = VT + ((size_t)((b * 8 + head) * 128 + (t >> 6))) * 8192 + e * 64 + (t & 48) + ((t >> 3) & 1) * 4;
                    u32x2 lo2, hi2; lo2.x = wv4.x; lo2.y = wv4.y; hi2.x = wv4.z; hi2.y = wv4.w;
                    *(u32x2*)vp = lo2; *(u32x2*)(vp + 8) = hi2;
                }
            }
    }
};
struct EpiOut {
    static constexpr bool PERM = true, AFTER_DRAIN = false;
    u16* mix;
    DI void operator()(const pg8::f32x4 (&acc)[2][2][4][2], const pg8::Unit& u, int wr, int wc, int fr, int fq) const {
#pragma unroll
        for (int ai = 0; ai < 2; ++ai)
#pragma unroll
            for (int m = 0; m < 4; ++m) {
                const int r = u.pm * 256 + ai * 128 + wr * 64 + m * 16 + fr;
#pragma unroll
                for (int bj = 0; bj < 2; ++bj) {
                    const pg8::f32x4 v0 = acc[ai][bj][m][0], v1 = acc[ai][bj][m][1];
                    u32x4 wv4; wv4.x = pk2(v0[0], v0[1]); wv4.y = pk2(v0[2], v0[3]); wv4.z = pk2(v1[0], v1[1]); wv4.w = pk2(v1[2], v1[3]);
                    *(u32x4*)(mix + (size_t)r * 1024 + u.pn * 256 + bj * 128 + wc * 32 + 8 * fq) = wv4;
                }
            }
    }
};

DI void phase_gemm1(const Params& p, char* lds, int wv) {
    const u16* HB = (const u16*)p.out;
    const u16* WIT = HB + (size_t)M_TOK * 1024;
    PG8_LAS unsigned char* l3 = (PG8_LAS unsigned char*)lds;
    pg8::StaticOrder S;
    {
        const pg8::Gemm g{HB, HB, WIT, M_TOK, 5888, 1024, 1024, 1 << 20};
        S.init(M_TOK, 5888, gridDim.x, blockIdx.x);
        pg8::gemm_phase<EpiProj, pg8::StaticOrder, true, true>(l3, g, S, EpiProj{p.ws}, wv);
    }
    {
        const pg8::Gemm g{WIT + (size_t)5888 * 1024, WIT + (size_t)5888 * 1024, HB, 1024, M_TOK, 1024, 1024, 1 << 20};
        S.init(1024, M_TOK, gridDim.x, blockIdx.x);
        pg8::gemm_phase<EpiVT, pg8::StaticOrder, true, true>(l3, g, S, EpiVT{p.ws}, wv);
    }
}

DI unsigned pair_pack(float x0, float x1, int odd) {
    const float send = odd ? x0 : x1;
    const float recv = __builtin_bit_cast(float, __builtin_amdgcn_mov_dpp(__builtin_bit_cast(int, send), 0xB1, 0xF, 0xF, true));
    return odd ? pk2(recv, x1) : pk2(x0, recv);
}

DI void ssdA_item(const Params& p, int item, char* lds, int wv) {
    const int tid = otid(wv), lane = tid & 63, w = __builtin_amdgcn_readfirstlane(tid >> 6), l31 = lane & 31, hh = lane >> 5;
    const int g = item & 1, c = (item >> 1) & 63, b = item >> 7;
    const int t0 = b * 8192 + c * 128;
    char* sB = lds; char* sC = lds + 34816; char* sBT = lds + 69632;
    float* tab = (float*)(lds + 104448);
    float* t_af = tab; float* t_ab = tab + 1024; float* t_df = tab + 2048; float* t_db = tab + 3072;
    float* part = (float*)(lds + 120832);
    const u16* XBC = (const u16*)(p.ws + OFF_XBC);
    const float* DT = (const float*)(p.ws + OFF_DT);
    float* EA = (float*)(p.ws + OFF_EA);
    float* DEC = (float*)(p.ws + OFF_DEC);
    u16* YL = (u16*)(p.ws + OFF_YL);
    u16* ST = (u16*)p.out;
    if (w >= 4) __builtin_amdgcn_s_setprio(1);
    {
        const int j = w, hd = g * 8 + j;
#pragma unroll
        for (int dir = 0; dir < 2; ++dir) {
            const float A = -expf(dir ? p.A_log_b[hd] : p.A_log_f[hd]) * LOG2E;
            const float bias = dir ? p.dt_bias_b[hd] : p.dt_bias_f[hd];
            const int col = dir * 16 + hd;
            const float d0 = softplusf(DT[(size_t)(t0 + lane) * 32 + col] + bias);
            const float d1 = softplusf(DT[(size_t)(t0 + lane + 64) * 32 + col] + bias);
            const float a0 = d0 * A, a1 = d1 * A;
            float s0 = a0, s1 = a1;
#pragma unroll
            for (int o = 1; o < 64; o <<= 1) {
                const float u0 = __shfl_up(s0, o), u1 = __shfl_up(s1, o);
                if (lane >= o) { s0 += u0; s1 += u1; }
            }
            const float tot0 = __shfl(s0, 63);
            s1 += tot0;
            const float total = __shfl(s1, 63);
            float e0, e1;
            if (dir == 0) { e0 = s0; e1 = s1; t_af[j * 128 + lane] = e0; t_af[j * 128 + lane + 64] = e1; t_df[j * 128 + lane] = d0; t_df[j * 128 + lane + 64] = d1; }
            else { e0 = total - (s0 - a0); e1 = total - (s1 - a1); t_ab[j * 128 + lane] = e0; t_ab[j * 128 + lane + 64] = e1; t_db[j * 128 + lane] = d0; t_db[j * 128 + lane + 64] = d1; }
            EA[(size_t)(t0 + lane) * 32 + col] = exp2f(e0);
            EA[(size_t)(t0 + lane + 64) * 32 + col] = exp2f(e1);
            if (lane == 0) DEC[((b * 16 + hd) * 2 + dir) * 64 + c] = exp2f(total);
        }
    }
    {
        const int cp = tid & 127, tg = tid >> 7;
        const bool isC = cp >= 64; const int n = 2 * (cp & 63);
        const int col = (isC ? 1280 : 1024) + g * 128 + n;
        float w0[5], w1[5];
#pragma unroll
        for (int k = 0; k < 5; ++k) { w0[k] = p.conv_w[k * 1536 + col]; w1[k] = p.conv_w[k * 1536 + col + 1]; }
        const float b0 = p.conv_b[col], b1 = p.conv_b[col + 1];
#pragma unroll 1
        for (int half = 0; half < 2; ++half) {
            const int lbase = tg * 32 + half * 16;
            unsigned win[20];
#pragma unroll
            for (int i = 0; i < 20; ++i) {
                const int lt = lbase - 2 + i, ts = c * 128 + lt;
                win[i] = (ts >= 0 && ts < 8192) ? *(const unsigned*)(XBC + (size_t)(t0 + lt) * 1536 + col) : 0u;
            }
#pragma unroll
            for (int i = 0; i < 16; ++i) {
                const int l = lbase + i;
                float v0 = b0, v1 = b1;
#pragma unroll
                for (int k = 0; k < 5; ++k) { v0 += w0[k] * bflo(win[i + k]); v1 += w1[k] * bfhi(win[i + k]); }
                v0 = siluf(v0); v1 = siluf(v1);
                const unsigned u = pk2(v0, v1);
                if (!isC) {
                    *(unsigned*)(sB + l * 272 + n * 2) = u;
                    *(u16*)(sBT + n * 272 + l * 2) = (u16)(u & 0xffffu);
                    *(u16*)(sBT + (n + 1) * 272 + l * 2) = (u16)(u >> 16);
                } else *(unsigned*)(sC + l * 272 + n * 2) = u;
            }
        }
    }
    __syncthreads();
    const int lb = w & 3, sh = w >> 2;
    f32x16 cbt[2];
#pragma unroll
    for (int sbl = 0; sbl < 2; ++sbl) {
        cbt[sbl] = zero16();
#pragma unroll
        for (int ks = 0; ks < 8; ++ks) {
            const bf16x8 a = *(const bf16x8*)(sB + ((sh * 2 + sbl) * 32 + l31) * 272 + (ks * 16 + hh * 8) * 2);
            const bf16x8 bq = *(const bf16x8*)(sC + (lb * 32 + l31) * 272 + (ks * 16 + hh * 8) * 2);
            cbt[sbl] = MFMA(a, bq, cbt[sbl]);
        }
    }
    __syncthreads();
    char* sX = lds; char* sXF = lds + 17408; char* sXB = lds + 34816;
    unsigned winn[12];
    {
        const int cp = tid & 31, tg = tid >> 5, lbase = tg * 8, col = (g * 8) * 64 + 2 * cp;
#pragma unroll
        for (int i = 0; i < 12; ++i) {
            const int lt = lbase - 2 + i, ts = c * 128 + lt;
            winn[i] = (ts >= 0 && ts < 8192) ? *(const unsigned*)(XBC + (size_t)(t0 + lt) * 1536 + col) : 0u;
        }
    }
#pragma unroll 1
    for (int j = 0; j < 8; ++j) {
        const int hd = g * 8 + j;
        {
            const int cp = tid & 31, tg = tid >> 5;
            const int col = hd * 64 + 2 * cp;
            float w0[5], w1[5];
#pragma unroll
            for (int k = 0; k < 5; ++k) { w0[k] = p.conv_w[k * 1536 + col]; w1[k] = p.conv_w[k * 1536 + col + 1]; }
            const float b0 = p.conv_b[col], b1 = p.conv_b[col + 1];
            const int lbase = tg * 8;
            unsigned win[12];
#pragma unroll
            for (int i = 0; i < 12; ++i) win[i] = winn[i];
            if (j < 7) {
#pragma unroll
                for (int i = 0; i < 12; ++i) {
                    const int lt = lbase - 2 + i, ts = c * 128 + lt;
                    winn[i] = (ts >= 0 && ts < 8192) ? *(const unsigned*)(XBC + (size_t)(t0 + lt) * 1536 + col + 64) : 0u;
                }
            }
            const float afend = t_af[j * 128 + 127], ab0 = t_ab[j * 128];
            float o0[8], o1[8];
#pragma unroll
            for (int i = 0; i < 8; ++i) {
                float v0 = b0, v1 = b1;
#pragma unroll
                for (int k = 0; k < 5; ++k) { v0 += w0[k] * bflo(win[i + k]); v1 += w1[k] * bfhi(win[i + k]); }
                o0[i] = siluf(v0); o1[i] = siluf(v1);
            }
            const int p0 = 2 * cp;
            *(bf16x8*)(sX + p0 * 272 + lbase * 2) = pack8(o0[0], o0[1], o0[2], o0[3], o0[4], o0[5], o0[6], o0[7]);
            *(bf16x8*)(sX + (p0 + 1) * 272 + lbase * 2) = pack8(o1[0], o1[1], o1[2], o1[3], o1[4], o1[5], o1[6], o1[7]);
            float wv[8];
#pragma unroll
            for (int i = 0; i < 8; ++i) wv[i] = t_df[j * 128 + lbase + i] * __builtin_amdgcn_exp2f(afend - t_af[j * 128 + lbase + i]);
            *(bf16x8*)(sXF + p0 * 272 + lbase * 2) = pack8(o0[0] * wv[0], o0[1] * wv[1], o0[2] * wv[2], o0[3] * wv[3], o0[4] * wv[4], o0[5] * wv[5], o0[6] * wv[6], o0[7] * wv[7]);
            *(bf16x8*)(sXF + (p0 + 1) * 272 + lbase * 2) = pack8(o1[0] * wv[0], o1[1] * wv[1], o1[2] * wv[2], o1[3] * wv[3], o1[4] * wv[4], o1[5] * wv[5], o1[6] * wv[6], o1[7] * wv[7]);
#pragma unroll
            for (int i = 0; i < 8; ++i) wv[i] = t_db[j * 128 + lbase + i] * __builtin_amdgcn_exp2f(ab0 - t_ab[j * 128 + lbase + i]);
            *(bf16x8*)(sXB + p0 * 272 + lbase * 2) = pack8(o0[0] * wv[0], o0[1] * wv[1], o0[2] * wv[2], o0[3] * wv[3], o0[4] * wv[4], o0[5] * wv[5], o0[6] * wv[6], o0[7] * wv[7]);
            *(bf16x8*)(sXB + (p0 + 1) * 272 + lbase * 2) = pack8(o1[0] * wv[0], o1[1] * wv[1], o1[2] * wv[2], o1[3] * wv[3], o1[4] * wv[4], o1[5] * wv[5], o1[6] * wv[6], o1[7] * wv[7]);
        }
        __syncthreads();
        f32x16 y[2]; y[0] = zero16(); y[1] = zero16();
        {
            const int l = lb * 32 + l31;
            const float afl = t_af[j * 128 + l], abl = t_ab[j * 128 + l];
            const float Dh = p.D[hd];
#pragma unroll
            for (int sbl = 0; sbl < 2; ++sbl) {
                const int sb = sh * 2 + sbl;
                float dloc = (float)((lb - sb) * 32 + l31 - 4 * hh);
                asm volatile("" : "+v"(dloc));
                float m[16];
#pragma unroll
                for (int grp = 0; grp < 4; ++grp) {
                    const int sbase = sb * 32 + 8 * grp + 4 * hh;
                    const f32x4 afs = *(const f32x4*)(t_af + j * 128 + sbase);
                    const f32x4 dfs = *(const f32x4*)(t_df + j * 128 + sbase);
                    const f32x4 abs_ = *(const f32x4*)(t_ab + j * 128 + sbase);
                    const f32x4 dbs = *(const f32x4*)(t_db + j * 128 + sbase);
#pragma unroll
                    for (int q = 0; q < 4; ++q) {
                        const float dq = dloc - (float)(8 * grp + q);
                        const float fm = __builtin_amdgcn_fmed3f(dq + 1.f, 0.f, 1.f), bm = __builtin_amdgcn_fmed3f(1.f - dq, 0.f, 1.f);
                        const float f = fm * __builtin_amdgcn_exp2f(fminf(afl - afs[q], 0.f)) * dfs[q];
                        const float bw = bm * __builtin_amdgcn_exp2f(fminf(abl - abs_[q], 0.f)) * dbs[q];
                        m[grp * 4 + q] = cbt[sbl][grp * 4 + q] * (f + bw) + fm * bm * Dh;
                    }
                    __builtin_amdgcn_sched_barrier(0);
                }
#pragma unroll
                for (int s2 = 0; s2 < 2; ++s2) {
                    const bf16x8 afrag = pack8(m[8 * s2], m[8 * s2 + 1], m[8 * s2 + 2], m[8 * s2 + 3], m[8 * s2 + 4], m[8 * s2 + 5], m[8 * s2 + 6], m[8 * s2 + 7]);
#pragma unroll
                    for (int pb = 0; pb < 2; ++pb) {
                        const char* xp = sX + (pb * 32 + l31) * 272 + (sb * 32 + 16 * s2 + 4 * hh) * 2;
                        const bf16x4 lo = *(const bf16x4*)xp, hi = *(const bf16x4*)(xp + 16);
                        const bf16x8 bfrag = __builtin_shufflevector(lo, hi, 0, 1, 2, 3, 4, 5, 6, 7);
                        y[pb] = MFMA(afrag, bfrag, y[pb]);
                    }
                }
                __builtin_amdgcn_sched_barrier(0);
            }
            if (sh == 1) {
#pragma unroll
                for (int pb = 0; pb < 2; ++pb)
#pragma unroll
                    for (int i = 0; i < 16; ++i) part[(lb * 32 + pb * 16 + i) * 64 + lane] = y[pb][i];
            }
        }
        {
            const int dir = w & 1, nblk = w >> 1;
            const char* xa = dir ? sXB : sXF;
            f32x16 st[2]; st[0] = zero16(); st[1] = zero16();
#pragma unroll
            for (int ks = 0; ks < 8; ++ks) {
                const bf16x8 bq = *(const bf16x8*)(sBT + (nblk * 32 + l31) * 272 + (ks * 16 + hh * 8) * 2);
#pragma unroll
                for (int pb2 = 0; pb2 < 2; ++pb2) {
                    const bf16x8 a = *(const bf16x8*)(xa + (pb2 * 32 + l31) * 272 + (ks * 16 + hh * 8) * 2);
                    st[pb2] = MFMA(a, bq, st[pb2]);
                }
            }
            u16* dst = ST + ((((size_t)(b * 16 + hd) * 2 + dir) * 64 + c) * 8192);
            const int odd = lane & 1;
#pragma unroll
            for (int pb2 = 0; pb2 < 2; ++pb2)
#pragma unroll
                for (int i = 0; i < 16; i += 2)
                    *(unsigned*)(dst + (pb2 * 32 + crow(i + odd, hh)) * 128 + nblk * 32 + l31 - odd) = pair_pack(st[pb2][i], st[pb2][i + 1], odd);
        }
        __syncthreads();
        if (sh == 0) {
#pragma unroll
            for (int pb = 0; pb < 2; ++pb)
                {
                    float v[16];
#pragma unroll
                    for (int i = 0; i < 16; ++i) v[i] = y[pb][i] + part[(lb * 32 + pb * 16 + i) * 64 + lane];
                    u16* yp = YL + (((((size_t)item * 8 + j) * 4 + lb) * 2 + pb) * 64 + lane) * 16;
                    *(bf16x8*)yp = pack8(v[0], v[1], v[2], v[3], v[4], v[5], v[6], v[7]);
                    *(bf16x8*)(yp + 8) = pack8(v[8], v[9], v[10], v[11], v[12], v[13], v[14], v[15]);
                }
        }
    }
    __builtin_amdgcn_s_setprio(0);
}

DI void phase_scan(const Params& p, int wv) {
    u16* ST = (u16*)p.out;
    const float* DEC = (const float*)(p.ws + OFF_DEC);
    const int nthreads = gridDim.x * 512;
    for (int e = blockIdx.x * 512 + otid(wv); e < 64 * 2048; e += nthreads) {
        const int combo = e >> 11, quad = e & 2047;
        u16* base = ST + (size_t)combo * (64 * 8192) + quad * 4;
        const float* dec = DEC + combo * 64;
        const bool bwd = combo & 1;
        float r0 = 0.f, r1 = 0.f, r2 = 0.f, r3 = 0.f;
        const int c0 = bwd ? 63 : 0, cs = bwd ? -1 : 1;
#pragma unroll 1
        for (int bt = 0; bt < 4; ++bt) {
            u32x2 v[16]; float d[16];
#pragma unroll
            for (int i = 0; i < 16; ++i) { const int ch = c0 + cs * (bt * 16 + i); v[i] = *(const u32x2*)(base + (size_t)ch * 8192); d[i] = dec[ch]; }
#pragma unroll
            for (int i = 0; i < 16; ++i) {
                u32x2 o; o.x = pk2(r0, r1); o.y = pk2(r2, r3);
                r0 = d[i] * r0 + bflo(v[i].x); r1 = d[i] * r1 + bfhi(v[i].x); r2 = d[i] * r2 + bflo(v[i].y); r3 = d[i] * r3 + bfhi(v[i].y);
                v[i] = o;
            }
#pragma unroll
            for (int i = 0; i < 16; ++i) { const int ch = c0 + cs * (bt * 16 + i); *(u32x2*)(base + (size_t)ch * 8192) = v[i]; }
        }
    }
    {
        const int tid = otid(wv), lane = tid & 63, w = __builtin_amdgcn_readfirstlane(tid >> 6);
        const u16* Kg = (const u16*)(p.ws + OFF_K);
        unsigned* KN = (unsigned*)(p.ws + OFF_KN);
        for (int cb = blockIdx.x; cb < 256; cb += gridDim.x) {
            float mx = 0.f;
#pragma unroll 4
            for (int i = 0; i < 8; ++i) {
                const int ch = cb * 64 + w * 8 + i;
                const u32x4 a = *(const u32x4*)(Kg + (size_t)ch * 1024 + lane * 16);
                const u32x4 c = *(const u32x4*)(Kg + (size_t)ch * 1024 + lane * 16 + 8);
                float ss = 0.f;
#pragma unroll
                for (int e = 0; e < 4; ++e) { const float x0 = bflo(a[e]), x1 = bfhi(a[e]), x2 = bflo(c[e]), x3 = bfhi(c[e]); ss += x0 * x0 + x1 * x1 + x2 * x2 + x3 * x3; }
                ss += __shfl_xor(ss, 1); ss += __shfl_xor(ss, 2);
                mx = fmaxf(mx, ss);
            }
#pragma unroll
            for (int o = 4; o < 64; o <<= 1) mx = fmaxf(mx, __shfl_xor(mx, o));
            if (lane == 0) atomicMax(&KN[cb >> 4], __float_as_uint(mx));
        }
    }
}

DI void ssdC_item(const Params& p, int item, char* lds, int wv) {
    const int tid = otid(wv), lane = tid & 63, w = __builtin_amdgcn_readfirstlane(tid >> 6), l31 = lane & 31, hh = lane >> 5;
    const int g = item & 1, c = (item >> 1) & 63, b = item >> 7;
    const int t0 = b * 8192 + c * 128;
    char* sC = lds;
    if (w >= 4) __builtin_amdgcn_s_setprio(1);
    float* ea = (float*)(lds + 34816);
    float* ssq = ea + 2048;
    float* rs = ssq + 1024;
    const u16* XBC = (const u16*)(p.ws + OFF_XBC);
    const float* EA = (const float*)(p.ws + OFF_EA);
    const u16* YL = (const u16*)(p.ws + OFF_YL);
    u16* Z = (u16*)(p.ws + OFF_Z);
    const u16* ST = (const u16*)p.out;
    for (int idx = tid; idx < 2048; idx += 512) {
        const int l = idx >> 4, cc = idx & 15, dir = cc >> 3, j = cc & 7;
        ea[(dir * 8 + j) * 128 + l] = EA[(size_t)(t0 + l) * 32 + dir * 16 + g * 8 + j];
    }
    {
        const int cp = tid & 63, tg = tid >> 6;
        const int n = 2 * cp, col = 1280 + g * 128 + n;
        float w0[5], w1[5];
#pragma unroll
        for (int k = 0; k < 5; ++k) { w0[k] = p.conv_w[k * 1536 + col]; w1[k] = p.conv_w[k * 1536 + col + 1]; }
        const float b0 = p.conv_b[col], b1 = p.conv_b[col + 1];
        const int lbase = tg * 16;
        unsigned win[20];
#pragma unroll
        for (int i = 0; i < 20; ++i) {
            const int lt = lbase - 2 + i, ts = c * 128 + lt;
            win[i] = (ts >= 0 && ts < 8192) ? *(const unsigned*)(XBC + (size_t)(t0 + lt) * 1536 + col) : 0u;
        }
#pragma unroll
        for (int i = 0; i < 16; ++i) {
            float v0 = b0, v1 = b1;
#pragma unroll
            for (int k = 0; k < 5; ++k) { v0 += w0[k] * bflo(win[i + k]); v1 += w1[k] * bfhi(win[i + k]); }
            *(unsigned*)(sC + (lbase + i) * 272 + n * 2) = pk2(siluf(v0), siluf(v1));
        }
    }
    __syncthreads();
    const int j = w, hd = g * 8 + j;
#pragma unroll 1
    for (int lh = 0; lh < 2; ++lh) {
        f32x16 y[2][2];
#pragma unroll
        for (int a = 0; a < 2; ++a) { y[a][0] = zero16(); y[a][1] = zero16(); }
#pragma unroll 1
        for (int dir = 0; dir < 2; ++dir) {
            const u16* prev = ST + ((((size_t)(b * 16 + hd) * 2 + dir) * 64 + c) * 8192);
            asm volatile("" ::: "memory");
            bf16x8 bfr[2][8];
#pragma unroll
            for (int pblk = 0; pblk < 2; ++pblk)
#pragma unroll
                for (int ks = 0; ks < 8; ++ks) bfr[pblk][ks] = *(const bf16x8*)(prev + (pblk * 32 + l31) * 128 + ks * 16 + hh * 8);
#pragma unroll
            for (int pblk = 0; pblk < 2; ++pblk) {
#pragma unroll
                for (int lb2 = 0; lb2 < 2; ++lb2) {
                    const int lbk = lh * 2 + lb2;
                    f32x16 acc = zero16();
#pragma unroll
                    for (int ks = 0; ks < 8; ++ks) {
                        const bf16x8 a = *(const bf16x8*)(sC + (lbk * 32 + l31) * 272 + (ks * 16 + hh * 8) * 2);
                        acc = MFMA(a, bfr[pblk][ks], acc);
                    }
#pragma unroll
                    for (int grp = 0; grp < 4; ++grp) {
                        const f32x4 e4 = *(const f32x4*)(ea + (dir * 8 + j) * 128 + lbk * 32 + 8 * grp + 4 * hh);
#pragma unroll
                        for (int q = 0; q < 4; ++q) y[lb2][pblk][grp * 4 + q] += e4[q] * acc[grp * 4 + q];
                    }
                }
            }
        }
        const int odd = lane & 1;
#pragma unroll
        for (int lb2 = 0; lb2 < 2; ++lb2) {
            u32x4 ylr[2][2];
#pragma unroll
            for (int pblk = 0; pblk < 2; ++pblk) {
                const u16* yp = YL + (((((size_t)item * 8 + j) * 4 + (lh * 2 + lb2)) * 2 + pblk) * 64 + lane) * 16;
                ylr[pblk][0] = *(const u32x4*)yp; ylr[pblk][1] = *(const u32x4*)(yp + 8);
            }
#pragma unroll
            for (int i = 0; i < 16; i += 2) {
                const int l0 = (lh * 2 + lb2) * 32 + crow(i, hh);
                float ss0 = 0.f, ss1 = 0.f;
#pragma unroll
                for (int pblk = 0; pblk < 2; ++pblk) {
                    const size_t idx = (size_t)(t0 + l0 + odd) * 1024 + hd * 64 + pblk * 32 + l31 - odd;
                    const unsigned lz = *(const unsigned*)(Z + idx);
                    const unsigned rz = (unsigned)__builtin_amdgcn_mov_dpp((int)lz, 0xB1, 0xF, 0xF, true);
                    const unsigned yw = ylr[pblk][i >> 3][(i >> 1) & 3];
                    const float yl0 = bflo(yw), yl1 = bfhi(yw);
                    const float z0 = odd ? bfhi(rz) : bflo(lz), z1 = odd ? bfhi(lz) : bflo(rz);
                    const float v0 = (y[lb2][pblk][i] + yl0) * siluf(z0), v1 = (y[lb2][pblk][i + 1] + yl1) * siluf(z1);
                    y[lb2][pblk][i] = v0; y[lb2][pblk][i + 1] = v1; ss0 += v0 * v0; ss1 += v1 * v1;
                }
#pragma unroll
                for (int o = 16; o > 0; o >>= 1) { ss0 += __shfl_xor(ss0, o); ss1 += __shfl_xor(ss1, o); }
                if (l31 == 0) { ssq[j * 128 + l0] = ss0; ssq[j * 128 + l0 + 1] = ss1; }
            }
            asm volatile("" ::: "memory");
        }
        __syncthreads();
        if (tid < 64) {
            const int l = lh * 64 + tid;
            float tot = 0.f;
#pragma unroll
            for (int jj = 0; jj < 8; ++jj) tot += ssq[jj * 128 + l];
            rs[l] = rsqrtf(tot * (1.f / 512.f) + 1e-5f);
        }
        __syncthreads();
#pragma unroll
        for (int pblk = 0; pblk < 2; ++pblk) {
            const float gain = p.ssm_norm_g[hd * 64 + pblk * 32 + l31];
#pragma unroll
            for (int lb2 = 0; lb2 < 2; ++lb2)
#pragma unroll
                for (int grp = 0; grp < 4; ++grp) {
                    const int lq = (lh * 2 + lb2) * 32 + 8 * grp + 4 * hh;
                    const f32x4 r4 = *(const f32x4*)(rs + lq);
#pragma unroll
                    for (int q = 0; q < 4; q += 2)
                        *(unsigned*)(Z + (size_t)(t0 + lq + q + odd) * 1024 + hd * 64 + pblk * 32 + l31 - odd) =
                            pair_pack(y[lb2][pblk][grp * 4 + q] * r4[q] * gain, y[lb2][pblk][grp * 4 + q + 1] * r4[q + 1] * gain, odd);
                }
        }
    }
    __syncthreads();
    __builtin_amdgcn_s_setprio(0);
}

DI void attn_item(const Params& p, int b, int h, int qb, float lam, char* lds, int wv) {
    const int tid = otid(wv), lane = tid & 63, w = __builtin_amdgcn_readfirstlane(tid >> 6), l31 = lane & 31, hh = lane >> 5;
    const int r = w & 1, qs = w >> 1;
    u16* Q = (u16*)(p.ws + OFF_Q);
    const u16* Kg = (const u16*)(p.ws + OFF_K);
    const u16* VT = (const u16*)(p.ws + OFF_VT);
    const u16* G = (const u16*)(p.ws + OFF_G);
    float* red = (float*)(lds + 131072);
    const int wq0 = qb * 128 + qs * 32;
    const int tq = wq0 + l31;
    const size_t row = (size_t)b * 8192 + tq;
    bf16x8 qf[4];
#pragma unroll
    for (int ks = 0; ks < 4; ++ks) qf[ks] = *(const bf16x8*)(Q + row * 1024 + h * 128 + r * 64 + ks * 16 + hh * 8);
    const float kn2 = __uint_as_float(((const unsigned*)(p.ws + OFF_KN))[b * 8 + h]);
    float mref;
    {
        float ss = 0.f, dg = 0.f;
#pragma unroll
        for (int ks = 0; ks < 4; ++ks) {
            const bf16x8 kd = *(const bf16x8*)(Kg + ((size_t)(b * 8 + h) * 8192 + tq) * 128 + r * 64 + ks * 16 + hh * 8);
#pragma unroll
            for (int e = 0; e < 8; ++e) { const float v = bf2f((u16)qf[ks][e]); ss += v * v; dg += v * bf2f((u16)kd[e]); }
        }
        ss += __shfl_xor(ss, 32); dg += __shfl_xor(dg, 32);
        mref = 0.5f * (sqrtf(ss * kn2) * 1.001f + dg);
#pragma unroll
        for (int o = 16; o > 0; o >>= 1) { ss = fmaxf(ss, __shfl_xor(ss, o)); dg = fminf(dg, __shfl_xor(dg, o)); }
        if (lane == 0) { red[w] = ss; red[8 + w] = dg; }
    }
    __syncthreads();
    float qn2 = red[0], dmin = red[8];
#pragma unroll
    for (int i = 1; i < 8; ++i) { qn2 = fmaxf(qn2, red[i]); dmin = fminf(dmin, red[8 + i]); }
    const float ms = __builtin_bit_cast(float, __builtin_amdgcn_readfirstlane(__builtin_bit_cast(int, exp2f(-(float)(h + 1)) * LOG2E)));
    const float Dw = fminf((1.001f * sqrtf(qn2 * kn2) - dmin + 40.f) / ms, 1e6f);
    const float q0f = (float)(qb * 128);
    int lo = (int)floorf((q0f - 63.f - Dw) * (1.f / 64.f)) + 1; lo = lo < 0 ? 0 : lo;
    int hi = (int)ceilf((q0f + 127.f + Dw) * (1.f / 64.f)) - 1; hi = hi > 127 ? 127 : hi;
    lo = __builtin_amdgcn_readfirstlane(lo); hi = __builtin_amdgcn_readfirstlane(hi);
    f32x16 O[4];
#pragma unroll
    for (int e = 0; e < 4; ++e) O[e] = zero16();
    float lsum = 0.f;
    const u16* kbase = Kg + (size_t)(b * 8 + h) * 8192 * 128;
    const u16* vbase = VT + (size_t)((b * 8 + h) * 128) * 8192;
    unsigned ksrc[2], vsrc[2];
#pragma unroll
    for (int j = 0; j < 2; ++j) {
        const int piece = w * 2 + j;
        const int key = piece * 4 + (lane >> 4), kpos = lane & 15;
        ksrc[j] = (unsigned)(key * 128 + ((kpos ^ (key & 15)) * 8));
        const int ev = piece * 8 + (lane >> 3), vpos = lane & 7;
        vsrc[j] = (unsigned)(ev * 64 + ((vpos ^ ((ev >> 1) & 7)) * 8));
    }
#define ADMA(kt, buf) do { \
    _Pragma("unroll") for (int j_ = 0; j_ < 2; ++j_) { \
        __builtin_amdgcn_global_load_lds((const unsigned*)(kbase + (size_t)(kt) * 8192 + ksrc[j_]), (LAS unsigned*)(lds + (buf) * 32768 + (w * 2 + j_) * 1024), 16, 0, 0); \
        __builtin_amdgcn_global_load_lds((const unsigned*)(vbase + (size_t)(kt) * 8192 + vsrc[j_]), (LAS unsigned*)(lds + (buf) * 32768 + 16384 + (w * 2 + j_) * 1024), 16, 0, 0); } } while (0)
#define SB __builtin_amdgcn_sched_barrier(0)
    const unsigned kx = (unsigned)(l31 * 256 + (l31 & 15) * 16);
    const unsigned vx = (unsigned)(l31 * 128 + ((l31 >> 1) & 7) * 16);
    f32x16 s[2];
    bf16x8 vf[4];
#define EXP8(KB, H8) do { _Pragma("unroll") for (int i_ = 0; i_ < 8; ++i_) { const float pv_ = __builtin_amdgcn_exp2f(s[KB][(H8) * 8 + i_]); s[KB][(H8) * 8 + i_] = pv_; psum += pv_; } } while (0)
#define PVG(G4) do { const int kb_ = (G4) >> 1, s2_ = (G4) & 1; \
        const bf16x8 pfrag = pack8(s[kb_][8 * s2_], s[kb_][8 * s2_ + 1], s[kb_][8 * s2_ + 2], s[kb_][8 * s2_ + 3], s[kb_][8 * s2_ + 4], s[kb_][8 * s2_ + 5], s[kb_][8 * s2_ + 6], s[kb_][8 * s2_ + 7]); \
        SB; \
        _Pragma("unroll") for (int e = 0; e < 4; ++e) O[e] = MFMA(vf[e], pfrag, O[e]); \
        SB; \
        if ((G4) < 3) { _Pragma("unroll") for (int e = 0; e < 4; ++e) vf[e] = *(const bf16x8*)(vsm + e * 4096 + (vx ^ (unsigned)((((G4) + 1) * 2 + hh) * 16))); } \
        } while (0)
#define TILE_BODY(KT, SLOT) do { \
        const char* ksm = lds + (SLOT) * 32768; const char* vsm = ksm + 16384; \
        const int k0 = (KT) * 64; \
        const float dl2 = (float)(k0 + 4 * hh - tq); \
        bf16x8 kf[2][4]; \
        _Pragma("unroll") for (int kb = 0; kb < 2; ++kb) \
        _Pragma("unroll") for (int ks = 0; ks < 4; ++ks) kf[kb][ks] = *(const bf16x8*)(ksm + kb * 8192 + (kx ^ (unsigned)((r * 8 + ks * 2 + hh) * 16))); \
        SB; \
        if (k0 + 63 < wq0 || k0 > wq0 + 31) { \
            const float sm = (k0 + 63 < wq0) ? ms : -ms; \
            const float tl = sm * dl2 - mref; \
            _Pragma("unroll") for (int kb = 0; kb < 2; ++kb) \
            _Pragma("unroll") for (int i = 0; i < 16; ++i) s[kb][i] = __builtin_fmaf(sm, (float)(kb * 32 + (i & 3) + 8 * (i >> 2)), tl); \
        } else { \
            _Pragma("unroll") for (int kb = 0; kb < 2; ++kb) \
            _Pragma("unroll") for (int i = 0; i < 16; ++i) s[kb][i] = __builtin_fmaf(-ms, fabsf(dl2 + (float)(kb * 32 + (i & 3) + 8 * (i >> 2))), -mref); \
        } \
        SB; \
        _Pragma("unroll") for (int kb = 0; kb < 2; ++kb) \
        _Pragma("unroll") for (int ks = 0; ks < 4; ++ks) s[kb] = MFMA(kf[kb][ks], qf[ks], s[kb]); \
        _Pragma("unroll") for (int e = 0; e < 4; ++e) vf[e] = *(const bf16x8*)(vsm + e * 4096 + (vx ^ (unsigned)(hh * 16))); \
        SB; \
        float psum = 0.f; \
        EXP8(0, 0); EXP8(0, 1); \
        SB; \
        PVG(0); SB; EXP8(1, 0); SB; \
        PVG(1); SB; EXP8(1, 1); SB; \
        PVG(2); SB; \
        PVG(3); SB; \
        lsum += psum; \
    } while (0)
    ADMA(lo, 0);
    if (lo < hi) ADMA(lo + 1, 1);
    asm volatile("s_waitcnt vmcnt(0)" ::: "memory");
    __builtin_amdgcn_s_barrier();
    asm volatile("" ::: "memory");
    if (w >= 4) __builtin_amdgcn_s_setprio(1);
    int sb0 = 0;
    for (int kt = lo; kt <= hi; kt += 2) {
        const int nb0 = sb0 ^ 2;
        if (kt + 2 <= hi) ADMA(kt + 2, nb0);
        if (kt + 3 <= hi) ADMA(kt + 3, nb0 + 1);
        SB;
        TILE_BODY(kt, sb0);
        if (kt + 1 <= hi) TILE_BODY(kt + 1, sb0 + 1);
        asm volatile("s_waitcnt vmcnt(0)" ::: "memory");
        __builtin_amdgcn_s_barrier();
        asm volatile("" ::: "memory");
        sb0 = nb0;
    }
#undef TILE_BODY
#undef EXP8
#undef PVG
    __builtin_amdgcn_s_setprio(0);
    __syncthreads();
#undef ADMA
#undef SB
    lsum += __shfl_xor(lsum, 32);
    const float inv = 1.f / lsum;
    float* X = (float*)lds;
    if (r == 1) {
        const float sc = *(volatile float*)(lds + 131072 + 128) * inv;
#pragma unroll
        for (int e = 0; e < 4; ++e)
#pragma unroll
            for (int i = 0; i < 16; ++i) X[(qs * 64 + e * 16 + i) * 64 + lane] = O[e][i] * sc;
    }
    __syncthreads();
    if (r == 0) {
        float ss = 0.f;
#pragma unroll
        for (int e = 0; e < 4; ++e)
#pragma unroll
            for (int i = 0; i < 16; ++i) { const float o = O[e][i] * inv - X[(qs * 64 + e * 16 + i) * 64 + lane]; O[e][i] = o; ss += o * o; }
        ss += __shfl_xor(ss, 32);
        const float rstd = rsqrtf(ss * (1.f / 128.f) + 1e-5f) * 0.8f;
#pragma unroll
        for (int e = 0; e < 4; ++e)
#pragma unroll
            for (int grp = 0; grp < 4; ++grp) {
                const int ee = e * 32 + 8 * grp + 4 * hh;
                const u32x2 gg = *(const u32x2*)(G + row * 1024 + h * 128 + ee);
                const f32x4 sg = *(const f32x4*)(p.subln_g + ee);
                const float o0 = O[e][grp * 4 + 0] * rstd * sg[0] * siluf(bflo(gg.x));
                const float o1 = O[e][grp * 4 + 1] * rstd * sg[1] * siluf(bfhi(gg.x));
                const float o2 = O[e][grp * 4 + 2] * rstd * sg[2] * siluf(bflo(gg.y));
                const float o3 = O[e][grp * 4 + 3] * rstd * sg[3] * siluf(bfhi(gg.y));
                u32x2 ov; ov.x = pk2(o0, o1); ov.y = pk2(o2, o3);
                *(u32x2*)(Q + row * 1024 + h * 128 + ee) = ov;
            }
    }
    __syncthreads();
}

DI void phase_attn(const Params& p, char* lds, int wv) {
    const int tid = otid(wv), lane = tid & 63;
    const float d1 = wsum(p.lq1[lane] * p.lk1[lane]);
    const float d2 = wsum(p.lq2[lane] * p.lk2[lane]);
    if (tid == 0) *(volatile float*)(lds + 131072 + 128) = expf(d1) - expf(d2) + 0.2f;
    const float lam = 0.f;
    unsigned* ctr = (unsigned*)(p.ws + OFF_CTR);
    volatile int* s_item = (volatile int*)(lds + 131072 + 64);
    for (;;) {
        if (tid == 0) *s_item = (int)atomicAdd(ctr, 1u);
        __syncthreads();
        const int it = *s_item;
        if (it >= 1024) break;
        const int h = 7 - (it >> 7), b = (it >> 6) & 1, qb = it & 63;
        attn_item(p, b, h, qb, lam, lds, wv);
    }
}

DI void phase_gemm2(const Params& p, char* lds, int wv) {
    const pg8::Gemm g{(const u16*)(p.ws + OFF_Z), (const u16*)(p.ws + OFF_Q), (const u16*)(p.ws + OFF_WOT), M_TOK, 1024, 2048, 1024, 16};
    pg8::StaticOrder S; S.init(M_TOK, 1024, gridDim.x, blockIdx.x);
    pg8::gemm_phase<EpiOut, pg8::StaticOrder, true, true>((PG8_LAS unsigned char*)lds, g, S, EpiOut{(u16*)(p.ws + OFF_YL)}, wv);
}

DI void phase_ln_out(const Params& p, int wv) {
    const int tid = otid(wv), lane = tid & 63, w = __builtin_amdgcn_readfirstlane(tid >> 6);
    const int nwaves = gridDim.x * 8;
    f32x4 ge[4], be[4], g2[4], b2[4];
#pragma unroll
    for (int j = 0; j < 4; ++j) {
        ge[j] = *(const f32x4*)(p.ln_emb_g + j * 256 + lane * 4); be[j] = *(const f32x4*)(p.ln_emb_b + j * 256 + lane * 4);
        g2[j] = *(const f32x4*)(p.ln_g + j * 256 + lane * 4); b2[j] = *(const f32x4*)(p.ln_b + j * 256 + lane * 4);
    }
    int row = blockIdx.x * 8 + w;
    f32x4 xv[4]; u32x2 mv[4];
    const u16* MIX = (const u16*)(p.ws + OFF_YL);
    if (row < M_TOK) {
#pragma unroll
        for (int j = 0; j < 4; ++j) { xv[j] = __builtin_nontemporal_load((const f32x4*)(p.x + (size_t)row * 1024 + j * 256 + lane * 4)); mv[j] = __builtin_nontemporal_load((const u32x2*)(MIX + (size_t)row * 1024 + j * 256 + lane * 4)); }
    }
    for (; row < M_TOK; row += nwaves) {
        f32x4 xc[4], mc[4];
#pragma unroll
        for (int j = 0; j < 4; ++j) { xc[j] = xv[j]; mc[j][0] = bflo(mv[j].x); mc[j][1] = bfhi(mv[j].x); mc[j][2] = bflo(mv[j].y); mc[j][3] = bfhi(mv[j].y); }
        const int nrow = row + nwaves;
        if (nrow < M_TOK) {
#pragma unroll
            for (int j = 0; j < 4; ++j) { xv[j] = __builtin_nontemporal_load((const f32x4*)(p.x + (size_t)nrow * 1024 + j * 256 + lane * 4)); mv[j] = __builtin_nontemporal_load((const u32x2*)(MIX + (size_t)nrow * 1024 + j * 256 + lane * 4)); }
        }
        float s = 0.f;
#pragma unroll
        for (int j = 0; j < 4; ++j) s += xc[j][0] + xc[j][1] + xc[j][2] + xc[j][3];
        s = wsum(s);
        const float mean = s * (1.f / 1024.f);
        float q = 0.f;
#pragma unroll
        for (int j = 0; j < 4; ++j)
#pragma unroll
            for (int e = 0; e < 4; ++e) { const float d = xc[j][e] - mean; q += d * d; }
        q = wsum(q);
        const float rstd = rsqrtf(q * (1.f / 1024.f) + 1e-5f);
        float s2 = 0.f;
#pragma unroll
        for (int j = 0; j < 4; ++j)
#pragma unroll
            for (int e = 0; e < 4; ++e) { const float v = ALPHA_DN * ((xc[j][e] - mean) * rstd * ge[j][e] + be[j][e]) + mc[j][e]; mc[j][e] = v; s2 += v; }
        s2 = wsum(s2);
        const float mean2 = s2 * (1.f / 1024.f);
        float q2 = 0.f;
#pragma unroll
        for (int j = 0; j < 4; ++j)
#pragma unroll
            for (int e = 0; e < 4; ++e) { const float d = mc[j][e] - mean2; q2 += d * d; }
        q2 = wsum(q2);
        const float rstd2 = rsqrtf(q2 * (1.f / 1024.f) + 1e-5f);
#pragma unroll
        for (int j = 0; j < 4; ++j) {
            f32x4 h;
#pragma unroll
            for (int e = 0; e < 4; ++e) h[e] = (mc[j][e] - mean2) * rstd2 * g2[j][e] + b2[j][e];
            __builtin_nontemporal_store(h, (f32x4*)(p.out + (size_t)row * 1024 + j * 256 + lane * 4));
        }
    }
}

__global__ void __launch_bounds__(512) hybrid_fwd(Params p) {
    extern __shared__ __attribute__((aligned(16))) char lds[];
    cg::grid_group grid = cg::this_grid();
    const int wv = __builtin_amdgcn_readfirstlane((int)(threadIdx.x >> 6));
#define GBAR() do { XcdBarrier b_; b_.bar = (unsigned*)(p.ws + OFF_BAR); b_.x = xb_xcc_id(); b_.st = (volatile LAS unsigned*)(lds + LDS_BYTES - 16); xcd_barrier(b_, otid(wv) == 0); } while (0)
    if (threadIdx.x == 0) { volatile LAS unsigned* xst = (volatile LAS unsigned*)(lds + LDS_BYTES - 16); xst[0] = 0u; xst[1] = 0u; }
    phase_prep(p, lds, wv);
    grid.sync();
    (void)xcd_barrier_post((unsigned*)(p.ws + OFF_BAR), (volatile LAS unsigned*)(lds + LDS_BYTES - 16), otid(wv) == 0);
    phase_gemm1(p, lds, wv);
    GBAR();
    for (int it = blockIdx.x; it < 256; it += gridDim.x) ssdA_item(p, it, lds, wv);
    GBAR();
    phase_scan(p, wv);
    GBAR();
    for (int it = blockIdx.x; it < 256; it += gridDim.x) ssdC_item(p, it, lds, wv);
    phase_attn(p, lds, wv);
    GBAR();
    phase_gemm2(p, lds, wv);
    GBAR();
    phase_ln_out(p, wv);
#undef GBAR
}

extern "C" void kernel_launch(void* const* d_in, const int* in_sizes, int n_in, void* d_out, int out_size, void* d_ws, size_t ws_size,
                              hipStream_t stream) {
    static int grid_blocks = 0;
    if (!grid_blocks) {
        int dev = 0, cus = 0, per_cu = 0;
        hipGetDevice(&dev);
        hipDeviceGetAttribute(&cus, hipDeviceAttributeMultiprocessorCount, dev);
        hipFuncSetAttribute((const void*)hybrid_fwd, hipFuncAttributeMaxDynamicSharedMemorySize, LDS_BYTES);
        hipOccupancyMaxActiveBlocksPerMultiprocessor(&per_cu, hybrid_fwd, 512, LDS_BYTES);
        if (per_cu > 1) per_cu = 1;
        grid_blocks = cus * per_cu;
        if (grid_blocks <= 0) grid_blocks = 256;
    }
    if (ws_size < WS_NEED) { fprintf(stderr, "workspace too small: %zu < %zu\n", ws_size, (size_t)WS_NEED); return; }
    Params p{};
    const float** f = (const float**)&p;
    for (int i = 0; i < 20; ++i) f[i] = (const float*)d_in[i];
    p.out = (float*)d_out;
    p.ws = (char*)d_ws;
    void* args[] = {&p};
    hipError_t e = hipLaunchCooperativeKernel((const void*)hybrid_fwd, dim3(grid_blocks), dim3(512), args, LDS_BYTES, stream);
    if (e != hipSuccess) fprintf(stderr, "cooperative launch failed: %s (grid %d)\n", hipGetErrorString(e), grid_blocks);
}
```

```cpp
#include <hip/hip_runtime.h>
#include <hip/hip_cooperative_groups.h>
#include <cstdio>
#include <cstdint>
namespace cg = cooperative_groups;

#define DI __device__ __forceinline__
typedef unsigned short u16;
typedef short bf16x8 __attribute__((ext_vector_type(8)));
typedef short bf16x4 __attribute__((ext_vector_type(4)));
typedef float f32x16 __attribute__((ext_vector_type(16)));
typedef float f32x4 __attribute__((ext_vector_type(4)));
typedef float f32x2 __attribute__((ext_vector_type(2)));
typedef __bf16 bf2_t __attribute__((ext_vector_type(2)));
typedef unsigned u32x4 __attribute__((ext_vector_type(4)));
typedef unsigned u32x2 __attribute__((ext_vector_type(2)));
#define MFMA(a, b, c) __builtin_amdgcn_mfma_f32_32x32x16_bf16((a), (b), (c), 0, 0, 0)

constexpr int M_TOK = 16384;
constexpr float LOG2E = 1.4426950408889634f;
constexpr float ALPHA_DN = 1.189207115002721f;

constexpr size_t SZ_ACT = (size_t)M_TOK * 1024 * 2;
constexpr size_t OFF_Z = 0;
constexpr size_t OFF_XBC = OFF_Z + SZ_ACT;
constexpr size_t OFF_Q = OFF_XBC + (size_t)M_TOK * 1536 * 2;
constexpr size_t OFF_K = OFF_Q + SZ_ACT;
constexpr size_t OFF_VT = OFF_K + SZ_ACT;
constexpr size_t OFF_G = OFF_VT + SZ_ACT;
constexpr size_t OFF_YL = OFF_G + SZ_ACT;
constexpr size_t OFF_DT = OFF_YL + SZ_ACT;
constexpr size_t OFF_EA = OFF_DT + (size_t)M_TOK * 32 * 4;
constexpr size_t OFF_WOT = OFF_EA + (size_t)M_TOK * 32 * 4;
constexpr size_t OFF_STATS = OFF_WOT + (size_t)1024 * 2048 * 2;
constexpr size_t OFF_DEC = OFF_STATS + (size_t)M_TOK * 2 * 4;
constexpr size_t OFF_KN = OFF_DEC + (size_t)2 * 16 * 2 * 64 * 4;
constexpr size_t OFF_CTR = OFF_KN + 256;
constexpr size_t OFF_BAR = OFF_CTR + 256;
constexpr size_t WS_NEED = OFF_BAR + 16384;
constexpr int LDS_BYTES = 153616;

struct Params {
    const float *x, *ln_emb_g, *ln_emb_b, *w_in, *conv_w, *conv_b, *A_log_f, *A_log_b, *dt_bias_f, *dt_bias_b, *D,
        *ssm_norm_g, *lq1, *lk1, *lq2, *lk2, *subln_g, *w_out, *ln_g, *ln_b;
    float* out;
    char* ws;
};

DI unsigned pk2(float lo, float hi) { f32x2 v = {lo, hi}; bf2_t b = __builtin_convertvector(v, bf2_t); return __builtin_bit_cast(unsigned, b); }
DI u16 tobf(float x) { return (u16)(pk2(x, 0.f) & 0xffffu); }
DI float bf2f(u16 v) { return __uint_as_float(((unsigned)v) << 16); }
DI float bflo(unsigned u) { return __uint_as_float(u << 16); }
DI float bfhi(unsigned u) { return __uint_as_float(u & 0xffff0000u); }
DI float wsum(float v) {
#pragma unroll
    for (int o = 32; o > 0; o >>= 1) v += __shfl_xor(v, o);
    return v;
}
DI float siluf(float v) { return v / (1.f + __expf(-v)); }
DI float softplusf(float x) { return x > 20.f ? x : log1pf(expf(x)); }
DI int otid(int wv) { int t = wv * 64 + (int)__builtin_amdgcn_mbcnt_hi(~0u, __builtin_amdgcn_mbcnt_lo(~0u, 0u)); asm volatile("" : "+v"(t)); return t; }
DI int crow(int i, int hh) { return (i & 3) + 8 * (i >> 2) + 4 * hh; }
DI bf16x8 pack8(float a0, float a1, float a2, float a3, float a4, float a5, float a6, float a7) {
    u32x4 p; p.x = pk2(a0, a1); p.y = pk2(a2, a3); p.z = pk2(a4, a5); p.w = pk2(a6, a7);
    return __builtin_bit_cast(bf16x8, p);
}
DI f32x16 zero16() { f32x16 z;
#pragma unroll
    for (int i = 0; i < 16; ++i) z[i] = 0.f;
    return z; }

#define XB_TMO      128
#define XB_XCNT(j)  (256  + 64 * (j))
#define XB_XSUB(j)  (1280 + 64 * (j))
#define XB_XGEN(j)  (2304 + 64 * (j))
#define XB_TOP      3328
#define XB_TOPGEN   3392
#define XCD_BAR_WORDS 3456
#define XB_SPIN_CAP (1u << 18)
#define LAS __attribute__((address_space(3)))

__device__ __forceinline__ unsigned xb_ld(unsigned* p)              { return __hip_atomic_load(p, __ATOMIC_RELAXED, __HIP_MEMORY_SCOPE_AGENT); }
__device__ __forceinline__ unsigned xb_add(unsigned* p, unsigned v) { return __hip_atomic_fetch_add(p, v, __ATOMIC_RELAXED, __HIP_MEMORY_SCOPE_AGENT); }
__device__ __forceinline__ unsigned xb_xcc_id() { return (unsigned)__builtin_amdgcn_s_getreg((3 << 11) | 20) & 0xFu; }
#define XB_SPIN(cond, bar) do { unsigned _sp = 0; while (cond) { __builtin_amdgcn_s_sleep(1); \
    if ((++_sp & 255u) == 0u) { if (xb_ld(&(bar)[XB_TMO])) break; if (_sp > XB_SPIN_CAP) { atomicAdd(&(bar)[XB_TMO], 1u); break; } } } } while (0)

struct XcdBarrier {
    unsigned* bar; unsigned x;
    volatile LAS unsigned* st;
};

__device__ __forceinline__ XcdBarrier xcd_barrier_post(unsigned* bar, volatile LAS unsigned* st, bool leader) {
    XcdBarrier b; b.bar = bar; b.x = xb_xcc_id(); b.st = st;
    if (leader) (void)xb_add(&bar[XB_XCNT(b.x)], 1u);
    return b;
}
__device__ __forceinline__ void xcd_barrier_complete(unsigned* bar, unsigned x, unsigned& nloc, unsigned& nx) {
    const unsigned G = gridDim.x * gridDim.y * gridDim.z;
    unsigned sum, cnt, mine, sp = 0u;
    for (;;) {
        sum = 0u; cnt = 0u; mine = 0u;
#pragma unroll
        for (unsigned j = 0; j < 16; ++j) { const unsigned c = xb_ld(&bar[XB_XCNT(j)]); sum += c; cnt += (c > 0u) ? 1u : 0u; mine = (j == x) ? c : mine; }
        if (sum == G) break;
        __builtin_amdgcn_s_sleep(1);
        if ((++sp & 255u) == 0u) { if (xb_ld(&bar[XB_TMO])) break; if (sp > XB_SPIN_CAP) { atomicAdd(&bar[XB_TMO], 1u); break; } }
    }
    nloc = mine > 0u ? mine : 1u; nx = cnt > 0u ? cnt : 1u;
}

__device__ __forceinline__ void xcd_barrier(const XcdBarrier& b, bool leader) {
    asm volatile("s_waitcnt vmcnt(0)" ::: "memory");
    __syncthreads();
    if (leader) {
        unsigned* bar = b.bar;
        __builtin_amdgcn_s_waitcnt(0);
        unsigned nloc = b.st[0], nx = b.st[1];
        if (nloc == 0u) { xcd_barrier_complete(bar, b.x, nloc, nx); b.st[0] = nloc; b.st[1] = nx; }
        const unsigned old = xb_add(&bar[XB_XSUB(b.x)], 1u);
        const unsigned gen = old / nloc;
        if (old + 1u == (gen + 1u) * nloc) {
            __builtin_amdgcn_fence(__ATOMIC_RELEASE, "agent");
            asm volatile("s_waitcnt vmcnt(0)" ::: "memory");
            const unsigned og = xb_add(&bar[XB_TOP], 1u);
            const unsigned tg = og / nx;
            if (og + 1u == (tg + 1u) * nx) xb_add(&bar[XB_TOPGEN], 1u);
            else XB_SPIN(xb_ld(&bar[XB_TOPGEN]) == tg, bar);
            __builtin_amdgcn_fence(__ATOMIC_ACQUIRE, "agent");
            xb_add(&bar[XB_XGEN(b.x)], 1u);
            asm volatile("s_waitcnt vmcnt(0)" ::: "memory");
        } else {
            XB_SPIN(xb_ld(&bar[XB_XGEN(b.x)]) == gen, bar);
            __builtin_amdgcn_fence(__ATOMIC_ACQUIRE, "agent");
            asm volatile("s_waitcnt vmcnt(0)" ::: "memory");
        }
    }
    __syncthreads();
}


DI void phase_prep(const Params& p, char* lds, int wv) {
    const int tid = otid(wv), lane = tid & 63, w = __builtin_amdgcn_readfirstlane(tid >> 6);
    u16* HB = (u16*)p.out;
    u16* WIT = HB + (size_t)M_TOK * 1024;
    u16* WOT = (u16*)(p.ws + OFF_WOT);
    const int nwaves = gridDim.x * 8;
    {
        f32x4 g4[4], b4[4], nx[4];
#pragma unroll
        for (int j = 0; j < 4; ++j) { g4[j] = *(const f32x4*)(p.ln_emb_g + j * 256 + lane * 4); b4[j] = *(const f32x4*)(p.ln_emb_b + j * 256 + lane * 4); }
        int row = blockIdx.x * 8 + w;
        if (row < M_TOK) {
#pragma unroll
            for (int j = 0; j < 4; ++j) nx[j] = __builtin_nontemporal_load((const f32x4*)(p.x + (size_t)row * 1024 + j * 256 + lane * 4));
        }
        for (; row < M_TOK; row += nwaves) {
            f32x4 v[4];
#pragma unroll
            for (int j = 0; j < 4; ++j) v[j] = nx[j];
            if (row + nwaves < M_TOK) {
#pragma unroll
                for (int j = 0; j < 4; ++j) nx[j] = __builtin_nontemporal_load((const f32x4*)(p.x + (size_t)(row + nwaves) * 1024 + j * 256 + lane * 4));
            }
            float s = 0.f;
#pragma unroll
            for (int j = 0; j < 4; ++j) s += v[j][0] + v[j][1] + v[j][2] + v[j][3];
            s = wsum(s);
            const float mean = s * (1.f / 1024.f);
            float q = 0.f;
#pragma unroll
            for (int j = 0; j < 4; ++j)
#pragma unroll
                for (int e = 0; e < 4; ++e) { float d = v[j][e] - mean; q += d * d; }
            q = wsum(q);
            const float rstd = rsqrtf(q * (1.f / 1024.f) + 1e-5f);
#pragma unroll
            for (int j = 0; j < 4; ++j) {
                f32x4 h;
#pragma unroll
                for (int e = 0; e < 4; ++e) h[e] = (v[j][e] - mean) * rstd * g4[j][e] + b4[j][e];
                u32x2 o; o.x = pk2(h[0], h[1]); o.y = pk2(h[2], h[3]);
                *(u32x2*)(HB + (size_t)row * 1024 + j * 256 + lane * 4) = o;
            }
        }
    }
    u16* T = (u16*)lds;
    const int n_tiles_in = 105 * 16, n_tiles_out = 16 * 32;
    for (int t = blockIdx.x; t < n_tiles_in + n_tiles_out; t += gridDim.x) {
        const float* W; int ldw, nsrc, k0, n0, ldd; u16* dst; bool isin = t < n_tiles_in;
        if (isin) { W = p.w_in; ldw = 6688; nsrc = 6688; k0 = (t & 15) * 64; n0 = (t >> 4) * 64; dst = WIT; ldd = 1024; }
        else { int u = t - n_tiles_in; W = p.w_out; ldw = 1024; nsrc = 1024; k0 = (u & 31) * 64; n0 = (u >> 5) * 64; dst = WOT; ldd = 2048; }
#pragma unroll
        for (int i = 0; i < 2; ++i) {
            const int e = tid + 512 * i, k = e >> 4, n4 = (e & 15) * 4;
            f32x4 v = {0.f, 0.f, 0.f, 0.f};
            if (n0 + n4 < nsrc) v = __builtin_nontemporal_load((const f32x4*)(W + (size_t)(k0 + k) * ldw + n0 + n4));
#pragma unroll
            for (int q = 0; q < 4; ++q) T[(n4 + q) * 66 + k] = tobf(v[q]);
        }
        __syncthreads();
        {
            const int n = tid >> 3, kc = (tid & 7) * 8, ns = n0 + n;
            if (ns < nsrc) {
                int nd = ns;
                if (isin) nd = (ns < 2560) ? ns : (ns < 2592) ? (ns + 3072) : (ns < 4640) ? (ns - 32) : (ns < 5664) ? (ns + 1248) : (ns - 1056);
                const unsigned* tp = (const unsigned*)(T + n * 66 + kc);
                u32x4 o; o.x = tp[0]; o.y = tp[1]; o.z = tp[2]; o.w = tp[3];
                *(u32x4*)(dst + (size_t)nd * ldd + k0 + kc) = o;
            }
        }
        __syncthreads();
    }
    if (blockIdx.x == 0) { if (tid < 128) ((unsigned*)(p.ws + OFF_KN))[tid] = 0u;
        for (int e = tid; e < 4096; e += 512) ((unsigned*)(p.ws + OFF_BAR))[e] = 0u; }
    for (int e = blockIdx.x * 512 + tid; e < 224 * 512; e += gridDim.x * 512) ((unsigned*)(WIT + (size_t)5664 * 1024))[e] = 0u;
}

namespace pg8 {
#define PG8_LAS __attribute__((address_space(3)))
typedef unsigned short bf16_t;
typedef short bf16x8 __attribute__((ext_vector_type(8)));
typedef float f32x4 __attribute__((ext_vector_type(4)));
typedef unsigned u32x4 __attribute__((ext_vector_type(4)));
constexpr int BM = 256, BK = 64, HALF = 128, HTB = HALF * BK * 2  , STAGE_BYTES = 8 * HTB, NXCD = 8, WGM = 8;

__host__ __device__ __forceinline__ int lds_byte(int r, int c) { const int st = (r >> 4) * 2 + (c >> 5), rr = r & 15, cc = c & 31, ob = rr * 64 + cc * 2; return st * 1024 + (ob ^ (((ob >> 9) & 1) << 5)); }
__host__ __device__ __forceinline__ void stage_rc(int b, int& R, int& C) { const int st = b / 1024, sb = b % 1024, swz = sb ^ (((sb >> 9) & 1) << 5); R = (st >> 1) * 16 + swz / 64; C = (st & 1) * 32 + (swz % 64) / 2; }
__host__ __device__ __forceinline__ int perm32(int rho) { const int n = rho >> 4, i = rho & 15; return 8 * (i >> 2) + 4 * n + (i & 3); }

struct Unit { int pm, pn; };
struct Gemm { const bf16_t* A; const bf16_t* A1; const bf16_t* Bt; int M, N, K, lda, ksplit; };

struct StaticOrder {
    int nM, nN, nwg, G, c;
    __host__ __device__ void init(int M, int N, int G_, int c_) { nM = M / BM; nN = N / BM; nwg = nM * nN; G = G_; c = c_; }
    __host__ __device__ bool next(int i, Unit& u) const {
        const long L = (long)i * G + c; if (L >= nwg) return false;
        int wgid = (int)L; { const int q = nwg / NXCD, r = nwg % NXCD, xcd = wgid % NXCD, off = wgid / NXCD; wgid = (xcd < r ? xcd * (q + 1) : r * (q + 1) + (xcd - r) * q) + off; }
        const int nig = WGM * nN, gid = wgid / nig, fm = gid * WGM, gsz = (nM - fm) < WGM ? (nM - fm) : WGM;
        u.pm = fm + ((wgid % nig) % gsz); u.pn = (wgid % nig) / gsz; return true;
    }
    __device__ __forceinline__ void a_ready(const Unit&) const {}
    __device__ __forceinline__ void done(const Unit&) const {}
};
template <class Epi, class Sched, bool ALIGN_EPI = false, bool SP2 = false>
__device__ __forceinline__ void gemm_phase(PG8_LAS unsigned char* lds, const Gemm g, const Sched& S, const Epi& E, int wv) {
    const int tid = otid(wv), wid = __builtin_amdgcn_readfirstlane(tid >> 6), lane = tid & 63, wr = wid >> 2, wc = wid & 3, fr = lane & 15, fq = lane >> 4;
    const int K = g.K, nt = K / BK;
    unsigned voffA[2], voffB[2];
#pragma unroll
    for (int i = 0; i < 2; ++i) { int R, C; stage_rc(tid * 16 + i * 8192, R, C); const int Rb = Epi::PERM ? ((R & ~31) + perm32(R & 31)) : R;
        voffA[i] = (unsigned)(R * g.lda + C) * 2u; voffB[i] = (unsigned)(Rb * K + C) * 2u; }
    const size_t kstep = (size_t)(BK * 2);
    const size_t hstep = (size_t)HALF * K * 2;
    const size_t tstep = 2 * hstep;
    const size_t hstepA = (size_t)HALF * g.lda * 2, tstepA = 2 * hstepA;
    const int ksp = g.ksplit;
#define PG8_AP(b0, b1, t_) (((t_) < ksp) ? ((b0) + (size_t)(t_) * kstep) : ((b1) + (size_t)((t_) - ksp) * kstep))
    const unsigned ldsw = (unsigned)wid * 1024u;
    const int aoff = lds_byte(wr * 64 + fr, fq * 8), boff = lds_byte(wc * 32 + fr, fq * 8);
#define PG8_SA(b, h) (((b) * 2 + (h)) * HTB)
#define PG8_SB(b, h) ((4 + (b) * 2 + (h)) * HTB)
#define PG8_STAGE(bufoff, gbase, voff) do { _Pragma("unroll") for (int _i = 0; _i < 2; ++_i) \
        __builtin_amdgcn_global_load_lds((const unsigned*)((const char*)(gbase) + (voff)[_i]), (PG8_LAS unsigned*)(lds + (bufoff) + ldsw + _i * 8192), 16, 0, 0); } while (0)
#define PG8_LDA(dst, b, h) do { _Pragma("unroll") for (int m = 0; m < 4; ++m) _Pragma("unroll") for (int k = 0; k < 2; ++k) dst[m][k] = *(const PG8_LAS bf16x8*)(lds + PG8_SA(b, h) + aoff + m * 2048 + k * 1024); } while (0)
#define PG8_LDB(dst, b, h) do { _Pragma("unroll") for (int n = 0; n < 2; ++n) _Pragma("unroll") for (int k = 0; k < 2; ++k) dst[n][k] = *(const PG8_LAS bf16x8*)(lds + PG8_SB(b, h) + boff + n * 2048 + k * 1024); } while (0)
#define PG8_MMA(ai, bj, At, Bt) do { __builtin_amdgcn_s_setprio(1); _Pragma("unroll") for (int m = 0; m < 4; ++m) _Pragma("unroll") for (int n = 0; n < 2; ++n) _Pragma("unroll") for (int k = 0; k < 2; ++k) \
        acc[ai][bj][m][n] = __builtin_amdgcn_mfma_f32_16x16x32_bf16(Bt[n][k], At[m][k], acc[ai][bj][m][n], 0, 0, 0); __builtin_amdgcn_s_setprio(0); } while (0)
#define PG8_WAIT_V(n) asm volatile("s_waitcnt vmcnt(" #n ")" ::: "memory")
#define PG8_WAIT_L(n) asm volatile("s_waitcnt lgkmcnt(" #n ")" ::: "memory")
#define PG8_BAR __builtin_amdgcn_s_barrier()
#define PG8_SCHED __builtin_amdgcn_sched_barrier(0)
    Unit cur, nxt; int ui = 0;
    if (!S.next(0, cur)) return;
    f32x4 acc[2][2][4][2];
#pragma unroll
    for (int a = 0; a < 2; ++a)
#pragma unroll
        for (int b = 0; b < 2; ++b)
#pragma unroll
            for (int m = 0; m < 4; ++m)
#pragma unroll
                for (int n = 0; n < 2; ++n) acc[a][b][m][n] = (f32x4){0.f, 0.f, 0.f, 0.f};
    bf16x8 At[4][2], B0[2][2], B1[2][2];
    const char* cA = (const char*)g.A + (size_t)cur.pm * tstepA; const char* cA1 = (const char*)g.A1 + (size_t)cur.pm * tstepA; const char* cB = (const char*)g.Bt + (size_t)cur.pn * tstep;
    S.a_ready(cur);
    if constexpr (SP2) {
        PG8_STAGE(PG8_SB(0, 0), cB, voffB); PG8_STAGE(PG8_SB(0, 1), cB + hstep, voffB); PG8_STAGE(PG8_SA(0, 0), cA, voffA); PG8_STAGE(PG8_SA(0, 1), cA + hstepA, voffA);
        if (wr == 1) PG8_BAR;
        PG8_WAIT_V(2); PG8_BAR;
        PG8_STAGE(PG8_SB(1, 0), cB + kstep, voffB); PG8_STAGE(PG8_SA(1, 0), PG8_AP(cA, cA1, 1), voffA); PG8_STAGE(PG8_SB(1, 1), cB + hstep + kstep, voffB);
        PG8_WAIT_V(6); PG8_BAR;
    } else {
        PG8_STAGE(PG8_SB(0, 0), cB, voffB); PG8_STAGE(PG8_SA(0, 0), cA, voffA); PG8_STAGE(PG8_SB(0, 1), cB + hstep, voffB); PG8_STAGE(PG8_SA(0, 1), cA + hstepA, voffA);
        if (wr == 1) PG8_BAR;
        PG8_WAIT_V(4); PG8_BAR;
        PG8_STAGE(PG8_SB(1, 0), cB + kstep, voffB); PG8_STAGE(PG8_SA(1, 0), PG8_AP(cA, cA1, 1), voffA); PG8_STAGE(PG8_SB(1, 1), cB + hstep + kstep, voffB);
        PG8_WAIT_V(6); PG8_BAR;
    }
    for (;;) {
        const bool has_next = S.next(ui + 1, nxt);
        const char* nA = has_next ? (const char*)g.A + (size_t)nxt.pm * tstepA : cA; const char* nA1 = has_next ? (const char*)g.A1 + (size_t)nxt.pm * tstepA : cA1; const char* nB = has_next ? (const char*)g.Bt + (size_t)nxt.pn * tstep : cB;
        for (int t = 0; t < nt; t += 2) {
            const bool last = (t == nt - 2);
            const char* a1 = PG8_AP(cA, cA1, t + 1);
            const char* a2 = last ? nA : PG8_AP(cA, cA1, t + 2); const char* b2 = last ? nB : cB + (size_t)(t + 2) * kstep;
            const char* a3 = a2 + kstep; const char* b3 = b2 + kstep;
            if (last && has_next) S.a_ready(nxt);
            if constexpr (SP2) {
            PG8_LDB(B0, 0, 0); PG8_LDB(B1, 0, 1); PG8_SCHED; PG8_LDA(At, 0, 0); PG8_STAGE(PG8_SA(1, 1), a1 + hstepA, voffA);
            PG8_WAIT_V(8); PG8_WAIT_L(0); PG8_BAR; PG8_MMA(0, 0, At, B0); PG8_MMA(0, 1, At, B1); PG8_BAR; PG8_SCHED;
            PG8_LDA(At, 0, 1); PG8_STAGE(PG8_SB(0, 0), b2, voffB); PG8_STAGE(PG8_SB(0, 1), b2 + hstep, voffB); PG8_STAGE(PG8_SA(0, 0), a2, voffA);
            PG8_WAIT_V(8); PG8_WAIT_L(0); PG8_BAR; PG8_MMA(1, 0, At, B0); PG8_MMA(1, 1, At, B1); PG8_BAR; PG8_SCHED;
            PG8_LDB(B0, 1, 0); PG8_LDB(B1, 1, 1); PG8_SCHED; PG8_LDA(At, 1, 0); PG8_STAGE(PG8_SA(0, 1), a2 + hstepA, voffA);
            PG8_WAIT_V(8); PG8_WAIT_L(0); PG8_BAR; PG8_MMA(0, 0, At, B0); PG8_MMA(0, 1, At, B1); PG8_BAR; PG8_SCHED;
            PG8_LDA(At, 1, 1); PG8_STAGE(PG8_SB(1, 0), b3, voffB); PG8_STAGE(PG8_SB(1, 1), b3 + hstep, voffB); PG8_STAGE(PG8_SA(1, 0), a3, voffA);
            PG8_WAIT_V(8); PG8_WAIT_L(0); PG8_BAR; PG8_MMA(1, 0, At, B0); PG8_MMA(1, 1, At, B1); PG8_BAR; PG8_SCHED;
            } else {
            PG8_LDB(B0, 0, 0); PG8_SCHED; PG8_LDA(At, 0, 0); PG8_STAGE(PG8_SA(1, 1), a1 + hstepA, voffA);
            PG8_WAIT_L(8); PG8_BAR; PG8_WAIT_L(0); PG8_MMA(0, 0, At, B0); PG8_BAR; PG8_SCHED;
            PG8_LDB(B1, 0, 1); PG8_STAGE(PG8_SB(0, 0), b2, voffB);
            PG8_BAR; PG8_WAIT_L(0); PG8_MMA(0, 1, At, B1); PG8_BAR;
            PG8_LDA(At, 0, 1); PG8_STAGE(PG8_SA(0, 0), a2, voffA);
            PG8_BAR; PG8_WAIT_L(0); PG8_MMA(1, 0, At, B0); PG8_BAR; PG8_SCHED;
            PG8_STAGE(PG8_SB(0, 1), b2 + hstep, voffB);
            PG8_WAIT_V(6); PG8_BAR; PG8_MMA(1, 1, At, B1); PG8_BAR;
            PG8_LDB(B0, 1, 0); PG8_SCHED; PG8_LDA(At, 1, 0); PG8_STAGE(PG8_SA(0, 1), a2 + hstepA, voffA);
            PG8_WAIT_L(8); PG8_BAR; PG8_WAIT_L(0); PG8_MMA(0, 0, At, B0); PG8_BAR; PG8_SCHED;
            PG8_LDB(B1, 1, 1); PG8_STAGE(PG8_SB(1, 0), b3, voffB);
            PG8_BAR; PG8_WAIT_L(0); PG8_MMA(0, 1, At, B1); PG8_BAR;
            PG8_LDA(At, 1, 1); PG8_STAGE(PG8_SA(1, 0), a3, voffA);
            PG8_BAR; PG8_WAIT_L(0); PG8_MMA(1, 0, At, B0); PG8_BAR; PG8_SCHED;
            PG8_STAGE(PG8_SB(1, 1), b3 + hstep, voffB);
            PG8_WAIT_V(6); PG8_BAR; PG8_MMA(1, 1, At, B1); PG8_BAR;
            }
        }
        if constexpr (ALIGN_EPI) { if (wr == 0) PG8_BAR; }
        if constexpr (!Epi::AFTER_DRAIN) { E(acc, cur, wr, wc, fr, fq); S.done(cur); }
        if (!has_next) break;
#pragma unroll
        for (int a = 0; a < 2; ++a)
#pragma unroll
            for (int b = 0; b < 2; ++b)
#pragma unroll
                for (int m = 0; m < 4; ++m)
#pragma unroll
                    for (int n = 0; n < 2; ++n) acc[a][b][m][n] = (f32x4){0.f, 0.f, 0.f, 0.f};
        cur = nxt; cA = nA; cA1 = nA1; cB = nB; ++ui;
        if constexpr (ALIGN_EPI) { if (wr == 1) PG8_BAR; }
    }
    PG8_WAIT_V(0);
    if constexpr (!ALIGN_EPI) { if (wr == 0) PG8_BAR; }
    PG8_BAR;
    if constexpr (Epi::AFTER_DRAIN) { E.fused(acc, cur, wr, wc, fr, fq, lds, wid, lane); S.done(cur); }
#undef PG8_AP
#undef PG8_SA
#undef PG8_SB
#undef PG8_STAGE
#undef PG8_LDA
#undef PG8_LDB
#undef PG8_MMA
#undef PG8_WAIT_V
#undef PG8_WAIT_L
#undef PG8_BAR
#undef PG8_SCHED
}
}


struct EpiProj {
    static constexpr bool PERM = true, AFTER_DRAIN = false;
    char* ws;
    DI void operator()(const pg8::f32x4 (&acc)[2][2][4][2], const pg8::Unit& u, int wr, int wc, int fr, int fq) const {
        const int pn = u.pn, row0 = u.pm * 256 + wr * 64 + fr;
        if (pn < 22) {
            u16* dst; int ld, cb; float sc = 1.f; const bool isk = (pn >= 14 && pn < 18);
            if (pn < 4) { dst = (u16*)(ws + OFF_Z); ld = 1024; cb = pn * 256; }
            else if (pn < 10) { dst = (u16*)(ws + OFF_XBC); ld = 1536; cb = (pn - 4) * 256; }
            else if (pn < 14) { dst = (u16*)(ws + OFF_Q); ld = 1024; cb = (pn - 10) * 256; sc = 0.125f * LOG2E; }
            else if (pn < 18) { dst = (u16*)(ws + OFF_K); ld = 128; cb = 0; }
            else { dst = (u16*)(ws + OFF_G); ld = 1024; cb = (pn - 18) * 256; }
#pragma unroll
            for (int ai = 0; ai < 2; ++ai)
#pragma unroll
                for (int m = 0; m < 4; ++m) {
                    const int r = row0 + ai * 128 + m * 16;
#pragma unroll
                    for (int bj = 0; bj < 2; ++bj) {
                        const size_t rowaddr = isk ? ((size_t)((r >> 13) * 8 + (pn - 14) * 2 + bj) * 8192 + (r & 8191)) : (size_t)r;
                        const int col = isk ? (wc * 32 + 8 * fq) : (cb + bj * 128 + wc * 32 + 8 * fq);
                        const pg8::f32x4 v0 = acc[ai][bj][m][0], v1 = acc[ai][bj][m][1];
                        u32x4 wv4; wv4.x = pk2(v0[0] * sc, v0[1] * sc); wv4.y = pk2(v0[2] * sc, v0[3] * sc); wv4.z = pk2(v1[0] * sc, v1[1] * sc); wv4.w = pk2(v1[2] * sc, v1[3] * sc);
                        __builtin_nontemporal_store(wv4, (u32x4*)(dst + rowaddr * ld + col));
                    }
                }
        } else if (wc == 0) {
            float* DT = (float*)(ws + OFF_DT);
#pragma unroll
            for (int ai = 0; ai < 2; ++ai)
#pragma unroll
                for (int m = 0; m < 4; ++m) {
                    const int r = row0 + ai * 128 + m * 16;
                    *(f32x4*)(DT + (size_t)r * 32 + 8 * fq) = acc[ai][0][m][0];
                    *(f32x4*)(DT + (size_t)r * 32 + 8 * fq + 4) = acc[ai][0][m][1];
                }
        }
    }
};
struct EpiVT {
    static constexpr bool PERM = true, AFTER_DRAIN = false;
    char* ws;
    DI void operator()(const pg8::f32x4 (&acc)[2][2][4][2], const pg8::Unit& u, int wr, int wc, int fr, int fq) const {
        u16* VT = (u16*)(ws + OFF_VT);
#pragma unroll
        for (int ai = 0; ai < 2; ++ai)
#pragma unroll
            for (int m = 0; m < 4; ++m) {
                const int eg = u.pm * 256 + ai * 128 + wr * 64 + m * 16 + fr, head = eg >> 7, e = eg & 127;
#pragma unroll
                for (int bj = 0; bj < 2; ++bj) {
                    const int tok = u.pn * 256 + bj * 128 + wc * 32 + 8 * fq, b = tok >> 13, t = tok & 8191;
                    const pg8::f32x4 v0 = acc[ai][bj][m][0], v1 = acc[ai][bj][m][1];
                    u32x4 wv4; wv4.x = pk2(v0[0], v0[1]); wv4.y = pk2(v0[2], v0[3]); wv4.z = pk2(v1[0], v1[1]); wv4.w = pk2(v1[2], v1[3]);
                    u16* vp = VT + ((size_t)((b * 8 + head) * 128 + (t >> 6))) * 8192 + e * 64 + (t & 48) + ((t >> 3) & 1) * 4;
                    u32x2 lo2, hi2; lo2.x = wv4.x; lo2.y = wv4.y; hi2.x = wv4.z; hi2.y = wv4.w;
                    __builtin_nontemporal_store(lo2, (u32x2*)vp); __builtin_nontemporal_store(hi2, (u32x2*)(vp + 8));
                }
            }
    }
};
struct EpiOut {
    static constexpr bool PERM = true, AFTER_DRAIN = false;
    u16* mix;
    DI void operator()(const pg8::f32x4 (&acc)[2][2][4][2], const pg8::Unit& u, int wr, int wc, int fr, int fq) const {
#pragma unroll
        for (int ai = 0; ai < 2; ++ai)
#pragma unroll
            for (int m = 0; m < 4; ++m) {
                const int r = u.pm * 256 + ai * 128 + wr * 64 + m * 16 + fr;
#pragma unroll
                for (int bj = 0; bj < 2; ++bj) {
                    const pg8::f32x4 v0 = acc[ai][bj][m][0], v1 = acc[ai][bj][m][1];
                    u32x4 wv4; wv4.x = pk2(v0[0], v0[1]); wv4.y = pk2(v0[2], v0[3]); wv4.z = pk2(v1[0], v1[1]); wv4.w = pk2(v1[2], v1[3]);
                    *(u32x4*)(mix + (size_t)r * 1024 + u.pn * 256 + bj * 128 + wc * 32 + 8 * fq) = wv4;
                }
            }
    }
};

DI void phase_gemm1(const Params& p, char* lds, int wv) {
    const u16* HB = (const u16*)p.out;
    const u16* WIT = HB + (size_t)M_TOK * 1024;
    PG8_LAS unsigned char* l3 = (PG8_LAS unsigned char*)lds;
    pg8::StaticOrder S;
    {
        const pg8::Gemm g{HB, HB, WIT, M_TOK, 5888, 1024, 1024, 1 << 20};
        S.init(M_TOK, 5888, gridDim.x, blockIdx.x);
        pg8::gemm_phase<EpiProj, pg8::StaticOrder, true, true>(l3, g, S, EpiProj{p.ws}, wv);
    }
    {
        const pg8::Gemm g{WIT + (size_t)5888 * 1024, WIT + (size_t)5888 * 1024, HB, 1024, M_TOK, 1024, 1024, 1 << 20};
        S.init(1024, M_TOK, gridDim.x, blockIdx.x);
        pg8::gemm_phase<EpiVT, pg8::StaticOrder, true, true>(l3, g, S, EpiVT{p.ws}, wv);
    }
}

DI unsigned pair_pack(float x0, float x1, int odd) {
    const float send = odd ? x0 : x1;
    const float recv = __builtin_bit_cast(float, __builtin_amdgcn_mov_dpp(__builtin_bit_cast(int, send), 0xB1, 0xF, 0xF, true));
    return odd ? pk2(recv, x1) : pk2(x0, recv);
}

DI void ssdA_item(const Params& p, int item, char* lds, int wv) {
    const int tid = otid(wv), lane = tid & 63, w = __builtin_amdgcn_readfirstlane(tid >> 6), l31 = lane & 31, hh = lane >> 5;
    const int g = item & 1, c = (item >> 1) & 63, b = item >> 7;
    const int t0 = b * 8192 + c * 128;
    char* sB = lds; char* sC = lds + 34816; char* sBT = lds + 69632;
    float* tab = (float*)(lds + 104448);
    float* t_af = tab; float* t_ab = tab + 1024; float* t_df = tab + 2048; float* t_db = tab + 3072;
    float* part = (float*)(lds + 120832);
    const u16* XBC = (const u16*)(p.ws + OFF_XBC);
    const float* DT = (const float*)(p.ws + OFF_DT);
    float* EA = (float*)(p.ws + OFF_EA);
    float* DEC = (float*)(p.ws + OFF_DEC);
    u16* YL = (u16*)(p.ws + OFF_YL);
    u16* ST = (u16*)p.out;
    if (w >= 4) __builtin_amdgcn_s_setprio(1);
    {
        const int j = w, hd = g * 8 + j;
#pragma unroll
        for (int dir = 0; dir < 2; ++dir) {
            const float A = -expf(dir ? p.A_log_b[hd] : p.A_log_f[hd]) * LOG2E;
            const float bias = dir ? p.dt_bias_b[hd] : p.dt_bias_f[hd];
            const int col = dir * 16 + hd;
            const float d0 = softplusf(DT[(size_t)(t0 + lane) * 32 + col] + bias);
            const float d1 = softplusf(DT[(size_t)(t0 + lane + 64) * 32 + col] + bias);
            const float a0 = d0 * A, a1 = d1 * A;
            float s0 = a0, s1 = a1;
#pragma unroll
            for (int o = 1; o < 64; o <<= 1) {
                const float u0 = __shfl_up(s0, o), u1 = __shfl_up(s1, o);
                if (lane >= o) { s0 += u0; s1 += u1; }
            }
            const float tot0 = __shfl(s0, 63);
            s1 += tot0;
            const float total = __shfl(s1, 63);
            float e0, e1;
            if (dir == 0) { e0 = s0; e1 = s1; t_af[j * 128 + lane] = e0; t_af[j * 128 + lane + 64] = e1; t_df[j * 128 + lane] = d0; t_df[j * 128 + lane + 64] = d1; }
            else { e0 = total - (s0 - a0); e1 = total - (s1 - a1); t_ab[j * 128 + lane] = e0; t_ab[j * 128 + lane + 64] = e1; t_db[j * 128 + lane] = d0; t_db[j * 128 + lane + 64] = d1; }
            EA[(size_t)(t0 + lane) * 32 + col] = exp2f(e0);
            EA[(size_t)(t0 + lane + 64) * 32 + col] = exp2f(e1);
            if (lane == 0) DEC[((b * 16 + hd) * 2 + dir) * 64 + c] = exp2f(total);
        }
    }
    {
        const int cp = tid & 127, tg = tid >> 7;
        const bool isC = cp >= 64; const int n = 2 * (cp & 63);
        const int col = (isC ? 1280 : 1024) + g * 128 + n;
        float w0[5], w1[5];
#pragma unroll
        for (int k = 0; k < 5; ++k) { w0[k] = p.conv_w[k * 1536 + col]; w1[k] = p.conv_w[k * 1536 + col + 1]; }
        const float b0 = p.conv_b[col], b1 = p.conv_b[col + 1];
#pragma unroll 1
        for (int half = 0; half < 2; ++half) {
            const int lbase = tg * 32 + half * 16;
            unsigned win[20];
#pragma unroll
            for (int i = 0; i < 20; ++i) {
                const int lt = lbase - 2 + i, ts = c * 128 + lt;
                win[i] = (ts >= 0 && ts < 8192) ? *(const unsigned*)(XBC + (size_t)(t0 + lt) * 1536 + col) : 0u;
            }
#pragma unroll
            for (int i = 0; i < 16; ++i) {
                const int l = lbase + i;
                float v0 = b0, v1 = b1;
#pragma unroll
                for (int k = 0; k < 5; ++k) { v0 += w0[k] * bflo(win[i + k]); v1 += w1[k] * bfhi(win[i + k]); }
                v0 = siluf(v0); v1 = siluf(v1);
                const unsigned u = pk2(v0, v1);
                if (!isC) {
                    *(unsigned*)(sB + l * 272 + n * 2) = u;
                    *(u16*)(sBT + n * 272 + l * 2) = (u16)(u & 0xffffu);
                    *(u16*)(sBT + (n + 1) * 272 + l * 2) = (u16)(u >> 16);
                } else *(unsigned*)(sC + l * 272 + n * 2) = u;
            }
        }
    }
    __syncthreads();
    const int lb = w & 3, sh = w >> 2;
    f32x16 cbt[2];
#pragma unroll
    for (int sbl = 0; sbl < 2; ++sbl) {
        cbt[sbl] = zero16();
#pragma unroll
        for (int ks = 0; ks < 8; ++ks) {
            const bf16x8 a = *(const bf16x8*)(sB + ((sh * 2 + sbl) * 32 + l31) * 272 + (ks * 16 + hh * 8) * 2);
            const bf16x8 bq = *(const bf16x8*)(sC + (lb * 32 + l31) * 272 + (ks * 16 + hh * 8) * 2);
            cbt[sbl] = MFMA(a, bq, cbt[sbl]);
        }
    }
    __syncthreads();
    char* sX = lds; char* sXF = lds + 17408; char* sXB = lds + 34816;
    unsigned winn[12];
    {
        const int cp = tid & 31, tg = tid >> 5, lbase = tg * 8, col = (g * 8) * 64 + 2 * cp;
#pragma unroll
        for (int i = 0; i < 12; ++i) {
            const int lt = lbase - 2 + i, ts = c * 128 + lt;
            winn[i] = (ts >= 0 && ts < 8192) ? *(const unsigned*)(XBC + (size_t)(t0 + lt) * 1536 + col) : 0u;
        }
    }
#pragma unroll 1
    for (int j = 0; j < 8; ++j) {
        const int hd = g * 8 + j;
        {
            const int cp = tid & 31, tg = tid >> 5;
            const int col = hd * 64 + 2 * cp;
            float w0[5], w1[5];
#pragma unroll
            for (int k = 0; k < 5; ++k) { w0[k] = p.conv_w[k * 1536 + col]; w1[k] = p.conv_w[k * 1536 + col + 1]; }
            const float b0 = p.conv_b[col], b1 = p.conv_b[col + 1];
            const int lbase = tg * 8;
            unsigned win[12];
#pragma unroll
            for (int i = 0; i < 12; ++i) win[i] = winn[i];
            if (j < 7) {
#pragma unroll
                for (int i = 0; i < 12; ++i) {
                    const int lt = lbase - 2 + i, ts = c * 128 + lt;
                    winn[i] = (ts >= 0 && ts < 8192) ? *(const unsigned*)(XBC + (size_t)(t0 + lt) * 1536 + col + 64) : 0u;
                }
            }
            const float afend = t_af[j * 128 + 127], ab0 = t_ab[j * 128];
            float o0[8], o1[8];
#pragma unroll
            for (int i = 0; i < 8; ++i) {
                float v0 = b0, v1 = b1;
#pragma unroll
                for (int k = 0; k < 5; ++k) { v0 += w0[k] * bflo(win[i + k]); v1 += w1[k] * bfhi(win[i + k]); }
                o0[i] = siluf(v0); o1[i] = siluf(v1);
            }
            const int p0 = 2 * cp;
            *(bf16x8*)(sX + p0 * 272 + lbase * 2) = pack8(o0[0], o0[1], o0[2], o0[3], o0[4], o0[5], o0[6], o0[7]);
            *(bf16x8*)(sX + (p0 + 1) * 272 + lbase * 2) = pack8(o1[0], o1[1], o1[2], o1[3], o1[4], o1[5], o1[6], o1[7]);
            float wv[8];
#pragma unroll
            for (int i = 0; i < 8; ++i) wv[i] = t_df[j * 128 + lbase + i] * __builtin_amdgcn_exp2f(afend - t_af[j * 128 + lbase + i]);
            *(bf16x8*)(sXF + p0 * 272 + lbase * 2) = pack8(o0[0] * wv[0], o0[1] * wv[1], o0[2] * wv[2], o0[3] * wv[3], o0[4] * wv[4], o0[5] * wv[5], o0[6] * wv[6], o0[7] * wv[7]);
            *(bf16x8*)(sXF + (p0 + 1) * 272 + lbase * 2) = pack8(o1[0] * wv[0], o1[1] * wv[1], o1[2] * wv[2], o1[3] * wv[3], o1[4] * wv[4], o1[5] * wv[5], o1[6] * wv[6], o1[7] * wv[7]);
#pragma unroll
            for (int i = 0; i < 8; ++i) wv[i] = t_db[j * 128 + lbase + i] * __builtin_amdgcn_exp2f(ab0 - t_ab[j * 128 + lbase + i]);
            *(bf16x8*)(sXB + p0 * 272 + lbase * 2) = pack8(o0[0] * wv[0], o0[1] * wv[1], o0[2] * wv[2], o0[3] * wv[3], o0[4] * wv[4], o0[5] * wv[5], o0[6] * wv[6], o0[7] * wv[7]);
            *(bf16x8*)(sXB + (p0 + 1) * 272 + lbase * 2) = pack8(o1[0] * wv[0], o1[1] * wv[1], o1[2] * wv[2], o1[3] * wv[3], o1[4] * wv[4], o1[5] * wv[5], o1[6] * wv[6], o1[7] * wv[7]);
        }
        __syncthreads();
        f32x16 y[2]; y[0] = zero16(); y[1] = zero16();
        {
            const int l = lb * 32 + l31;
            const float afl = t_af[j * 128 + l], abl = t_ab[j * 128 + l];
            const float Dh = p.D[hd];
#pragma unroll
            for (int sbl = 0; sbl < 2; ++sbl) {
                const int sb = sh * 2 + sbl;
                float dloc = (float)((lb - sb) * 32 + l31 - 4 * hh);
                asm volatile("" : "+v"(dloc));
                float m[16];
#pragma unroll
                for (int grp = 0; grp < 4; ++grp) {
                    const int sbase = sb * 32 + 8 * grp + 4 * hh;
                    const f32x4 afs = *(const f32x4*)(t_af + j * 128 + sbase);
                    const f32x4 dfs = *(const f32x4*)(t_df + j * 128 + sbase);
                    const f32x4 abs_ = *(const f32x4*)(t_ab + j * 128 + sbase);
                    const f32x4 dbs = *(const f32x4*)(t_db + j * 128 + sbase);
#pragma unroll
                    for (int q = 0; q < 4; ++q) {
                        const float dq = dloc - (float)(8 * grp + q);
                        const float fm = __builtin_amdgcn_fmed3f(dq + 1.f, 0.f, 1.f), bm = __builtin_amdgcn_fmed3f(1.f - dq, 0.f, 1.f);
                        const float f = fm * __builtin_amdgcn_exp2f(fminf(afl - afs[q], 0.f)) * dfs[q];
                        const float bw = bm * __builtin_amdgcn_exp2f(fminf(abl - abs_[q], 0.f)) * dbs[q];
                        m[grp * 4 + q] = cbt[sbl][grp * 4 + q] * (f + bw) + fm * bm * Dh;
                    }
                    __builtin_amdgcn_sched_barrier(0);
                }
#pragma unroll
                for (int s2 = 0; s2 < 2; ++s2) {
                    const bf16x8 afrag = pack8(m[8 * s2], m[8 * s2 + 1], m[8 * s2 + 2], m[8 * s2 + 3], m[8 * s2 + 4], m[8 * s2 + 5], m[8 * s2 + 6], m[8 * s2 + 7]);
#pragma unroll
                    for (int pb = 0; pb < 2; ++pb) {
                        const char* xp = sX + (pb * 32 + l31) * 272 + (sb * 32 + 16 * s2 + 4 * hh) * 2;
                        const bf16x4 lo = *(const bf16x4*)xp, hi = *(const bf16x4*)(xp + 16);
                        const bf16x8 bfrag = __builtin_shufflevector(lo, hi, 0, 1, 2, 3, 4, 5, 6, 7);
                        y[pb] = MFMA(afrag, bfrag, y[pb]);
                    }
                }
                __builtin_amdgcn_sched_barrier(0);
            }
            if (sh == 1) {
#pragma unroll
                for (int pb = 0; pb < 2; ++pb)
#pragma unroll
                    for (int i = 0; i < 16; ++i) part[(lb * 32 + pb * 16 + i) * 64 + lane] = y[pb][i];
            }
        }
        {
            const int dir = w & 1, nblk = w >> 1;
            const char* xa = dir ? sXB : sXF;
            f32x16 st[2]; st[0] = zero16(); st[1] = zero16();
#pragma unroll
            for (int ks = 0; ks < 8; ++ks) {
                const bf16x8 bq = *(const bf16x8*)(sBT + (nblk * 32 + l31) * 272 + (ks * 16 + hh * 8) * 2);
#pragma unroll
                for (int pb2 = 0; pb2 < 2; ++pb2) {
                    const bf16x8 a = *(const bf16x8*)(xa + (pb2 * 32 + l31) * 272 + (ks * 16 + hh * 8) * 2);
                    st[pb2] = MFMA(a, bq, st[pb2]);
                }
            }
            u16* dst = ST + ((((size_t)(b * 16 + hd) * 2 + dir) * 64 + c) * 8192);
            const int odd = lane & 1;
#pragma unroll
            for (int pb2 = 0; pb2 < 2; ++pb2)
#pragma unroll
                for (int i = 0; i < 16; i += 2)
                    *(unsigned*)(dst + (pb2 * 32 + crow(i + odd, hh)) * 128 + nblk * 32 + l31 - odd) = pair_pack(st[pb2][i], st[pb2][i + 1], odd);
        }
        __syncthreads();
        if (sh == 0) {
#pragma unroll
            for (int pb = 0; pb < 2; ++pb)
                {
                    float v[16];
#pragma unroll
                    for (int i = 0; i < 16; ++i) v[i] = y[pb][i] + part[(lb * 32 + pb * 16 + i) * 64 + lane];
                    u16* yp = YL + (((((size_t)item * 8 + j) * 4 + lb) * 2 + pb) * 64 + lane) * 16;
                    *(bf16x8*)yp = pack8(v[0], v[1], v[2], v[3], v[4], v[5], v[6], v[7]);
                    *(bf16x8*)(yp + 8) = pack8(v[8], v[9], v[10], v[11], v[12], v[13], v[14], v[15]);
                }
        }
    }
    __builtin_amdgcn_s_setprio(0);
}

DI void phase_scan(const Params& p, int wv) {
    u16* ST = (u16*)p.out;
    const float* DEC = (const float*)(p.ws + OFF_DEC);
    const int nthreads = gridDim.x * 512;
    for (int e = blockIdx.x * 512 + otid(wv); e < 64 * 2048; e += nthreads) {
        const int combo = e >> 11, quad = e & 2047;
        u16* base = ST + (size_t)combo * (64 * 8192) + quad * 4;
        const float* dec = DEC + combo * 64;
        const bool bwd = combo & 1;
        float r0 = 0.f, r1 = 0.f, r2 = 0.f, r3 = 0.f;
        const int c0 = bwd ? 63 : 0, cs = bwd ? -1 : 1;
#pragma unroll 1
        for (int bt = 0; bt < 4; ++bt) {
            u32x2 v[16]; float d[16];
#pragma unroll
            for (int i = 0; i < 16; ++i) { const int ch = c0 + cs * (bt * 16 + i); v[i] = *(const u32x2*)(base + (size_t)ch * 8192); d[i] = dec[ch]; }
#pragma unroll
            for (int i = 0; i < 16; ++i) {
                u32x2 o; o.x = pk2(r0, r1); o.y = pk2(r2, r3);
                r0 = d[i] * r0 + bflo(v[i].x); r1 = d[i] * r1 + bfhi(v[i].x); r2 = d[i] * r2 + bflo(v[i].y); r3 = d[i] * r3 + bfhi(v[i].y);
                v[i] = o;
            }
#pragma unroll
            for (int i = 0; i < 16; ++i) { const int ch = c0 + cs * (bt * 16 + i); *(u32x2*)(base + (size_t)ch * 8192) = v[i]; }
        }
    }
    {
        const int tid = otid(wv), lane = tid & 63, w = __builtin_amdgcn_readfirstlane(tid >> 6);
        const u16* Kg = (const u16*)(p.ws + OFF_K);
        unsigned* KN = (unsigned*)(p.ws + OFF_KN);
        for (int cb = blockIdx.x; cb < 256; cb += gridDim.x) {
            float mx = 0.f;
#pragma unroll 4
            for (int i = 0; i < 8; ++i) {
                const int ch = cb * 64 + w * 8 + i;
                const u32x4 a = *(const u32x4*)(Kg + (size_t)ch * 1024 + lane * 16);
                const u32x4 c = *(const u32x4*)(Kg + (size_t)ch * 1024 + lane * 16 + 8);
                float ss = 0.f;
#pragma unroll
                for (int e = 0; e < 4; ++e) { const float x0 = bflo(a[e]), x1 = bfhi(a[e]), x2 = bflo(c[e]), x3 = bfhi(c[e]); ss += x0 * x0 + x1 * x1 + x2 * x2 + x3 * x3; }
                ss += __shfl_xor(ss, 1); ss += __shfl_xor(ss, 2);
                mx = fmaxf(mx, ss);
            }
#pragma unroll
            for (int o = 4; o < 64; o <<= 1) mx = fmaxf(mx, __shfl_xor(mx, o));
            if (lane == 0) atomicMax(&KN[cb >> 4], __float_as_uint(mx));
        }
    }
}

DI void ssdC_item(const Params& p, int item, char* lds, int wv) {
    const int tid = otid(wv), lane = tid & 63, w = __builtin_amdgcn_readfirstlane(tid >> 6), l31 = lane & 31, hh = lane >> 5;
    const int g = item & 1, c = (item >> 1) & 63, b = item >> 7;
    const int t0 = b * 8192 + c * 128;
    char* sC = lds;
    if (w >= 4) __builtin_amdgcn_s_setprio(1);
    float* ea = (float*)(lds + 34816);
    float* ssq = ea + 2048;
    float* rs = ssq + 1024;
    const u16* XBC = (const u16*)(p.ws + OFF_XBC);
    const float* EA = (const float*)(p.ws + OFF_EA);
    const u16* YL = (const u16*)(p.ws + OFF_YL);
    u16* Z = (u16*)(p.ws + OFF_Z);
    const u16* ST = (const u16*)p.out;
    for (int idx = tid; idx < 2048; idx += 512) {
        const int l = idx >> 4, cc = idx & 15, dir = cc >> 3, j = cc & 7;
        ea[(dir * 8 + j) * 128 + l] = EA[(size_t)(t0 + l) * 32 + dir * 16 + g * 8 + j];
    }
    {
        const int cp = tid & 63, tg = tid >> 6;
        const int n = 2 * cp, col = 1280 + g * 128 + n;
        float w0[5], w1[5];
#pragma unroll
        for (int k = 0; k < 5; ++k) { w0[k] = p.conv_w[k * 1536 + col]; w1[k] = p.conv_w[k * 1536 + col + 1]; }
        const float b0 = p.conv_b[col], b1 = p.conv_b[col + 1];
        const int lbase = tg * 16;
        unsigned win[20];
#pragma unroll
        for (int i = 0; i < 20; ++i) {
            const int lt = lbase - 2 + i, ts = c * 128 + lt;
            win[i] = (ts >= 0 && ts < 8192) ? *(const unsigned*)(XBC + (size_t)(t0 + lt) * 1536 + col) : 0u;
        }
#pragma unroll
        for (int i = 0; i < 16; ++i) {
            float v0 = b0, v1 = b1;
#pragma unroll
            for (int k = 0; k < 5; ++k) { v0 += w0[k] * bflo(win[i + k]); v1 += w1[k] * bfhi(win[i + k]); }
            *(unsigned*)(sC + (lbase + i) * 272 + n * 2) = pk2(siluf(v0), siluf(v1));
        }
    }
    __syncthreads();
    const int j = w, hd = g * 8 + j;
#pragma unroll 1
    for (int lh = 0; lh < 2; ++lh) {
        f32x16 y[2][2];
#pragma unroll
        for (int a = 0; a < 2; ++a) { y[a][0] = zero16(); y[a][1] = zero16(); }
#pragma unroll 1
        for (int dir = 0; dir < 2; ++dir) {
            const u16* prev = ST + ((((size_t)(b * 16 + hd) * 2 + dir) * 64 + c) * 8192);
            asm volatile("" ::: "memory");
            bf16x8 bfr[2][8];
#pragma unroll
            for (int pblk = 0; pblk < 2; ++pblk)
#pragma unroll
                for (int ks = 0; ks < 8; ++ks) bfr[pblk][ks] = *(const bf16x8*)(prev + (pblk * 32 + l31) * 128 + ks * 16 + hh * 8);
#pragma unroll
            for (int pblk = 0; pblk < 2; ++pblk) {
#pragma unroll
                for (int lb2 = 0; lb2 < 2; ++lb2) {
                    const int lbk = lh * 2 + lb2;
                    f32x16 acc = zero16();
#pragma unroll
                    for (int ks = 0; ks < 8; ++ks) {
                        const bf16x8 a = *(const bf16x8*)(sC + (lbk * 32 + l31) * 272 + (ks * 16 + hh * 8) * 2);
                        acc = MFMA(a, bfr[pblk][ks], acc);
                    }
#pragma unroll
                    for (int grp = 0; grp < 4; ++grp) {
                        const f32x4 e4 = *(const f32x4*)(ea + (dir * 8 + j) * 128 + lbk * 32 + 8 * grp + 4 * hh);
#pragma unroll
                        for (int q = 0; q < 4; ++q) y[lb2][pblk][grp * 4 + q] += e4[q] * acc[grp * 4 + q];
                    }
                }
            }
        }
        const int odd = lane & 1;
#pragma unroll
        for (int lb2 = 0; lb2 < 2; ++lb2) {
            u32x4 ylr[2][2];
#pragma unroll
            for (int pblk = 0; pblk < 2; ++pblk) {
                const u16* yp = YL + (((((size_t)item * 8 + j) * 4 + (lh * 2 + lb2)) * 2 + pblk) * 64 + lane) * 16;
                ylr[pblk][0] = *(const u32x4*)yp; ylr[pblk][1] = *(const u32x4*)(yp + 8);
            }
#pragma unroll
            for (int i = 0; i < 16; i += 2) {
                const int l0 = (lh * 2 + lb2) * 32 + crow(i, hh);
                float ss0 = 0.f, ss1 = 0.f;
#pragma unroll
                for (int pblk = 0; pblk < 2; ++pblk) {
                    const size_t idx = (size_t)(t0 + l0 + odd) * 1024 + hd * 64 + pblk * 32 + l31 - odd;
                    const unsigned lz = *(const unsigned*)(Z + idx);
                    const unsigned rz = (unsigned)__builtin_amdgcn_mov_dpp((int)lz, 0xB1, 0xF, 0xF, true);
                    const unsigned yw = ylr[pblk][i >> 3][(i >> 1) & 3];
                    const float yl0 = bflo(yw), yl1 = bfhi(yw);
                    const float z0 = odd ? bfhi(rz) : bflo(lz), z1 = odd ? bfhi(lz) : bflo(rz);
                    const float v0 = (y[lb2][pblk][i] + yl0) * siluf(z0), v1 = (y[lb2][pblk][i + 1] + yl1) * siluf(z1);
                    y[lb2][pblk][i] = v0; y[lb2][pblk][i + 1] = v1; ss0 += v0 * v0; ss1 += v1 * v1;
                }
#pragma unroll
                for (int o = 16; o > 0; o >>= 1) { ss0 += __shfl_xor(ss0, o); ss1 += __shfl_xor(ss1, o); }
                if (l31 == 0) { ssq[j * 128 + l0] = ss0; ssq[j * 128 + l0 + 1] = ss1; }
            }
            asm volatile("" ::: "memory");
        }
        __syncthreads();
        if (tid < 64) {
            const int l = lh * 64 + tid;
            float tot = 0.f;
#pragma unroll
            for (int jj = 0; jj < 8; ++jj) tot += ssq[jj * 128 + l];
            rs[l] = rsqrtf(tot * (1.f / 512.f) + 1e-5f);
        }
        __syncthreads();
#pragma unroll
        for (int pblk = 0; pblk < 2; ++pblk) {
            const float gain = p.ssm_norm_g[hd * 64 + pblk * 32 + l31];
#pragma unroll
            for (int lb2 = 0; lb2 < 2; ++lb2)
#pragma unroll
                for (int grp = 0; grp < 4; ++grp) {
                    const int lq = (lh * 2 + lb2) * 32 + 8 * grp + 4 * hh;
                    const f32x4 r4 = *(const f32x4*)(rs + lq);
#pragma unroll
                    for (int q = 0; q < 4; q += 2)
                        *(unsigned*)(Z + (size_t)(t0 + lq + q + odd) * 1024 + hd * 64 + pblk * 32 + l31 - odd) =
                            pair_pack(y[lb2][pblk][grp * 4 + q] * r4[q] * gain, y[lb2][pblk][grp * 4 + q + 1] * r4[q + 1] * gain, odd);
                }
        }
    }
    __syncthreads();
    __builtin_amdgcn_s_setprio(0);
}

DI void attn_item(const Params& p, int b, int h, int qb, float lam, char* lds, int wv) {
    const int tid = otid(wv), lane = tid & 63, w = __builtin_amdgcn_readfirstlane(tid >> 6), l31 = lane & 31, hh = lane >> 5;
    const int r = w & 1, qs = w >> 1;
    u16* Q = (u16*)(p.ws + OFF_Q);
    const u16* Kg = (const u16*)(p.ws + OFF_K);
    const u16* VT = (const u16*)(p.ws + OFF_VT);
    const u16* G = (const u16*)(p.ws + OFF_G);
    float* red = (float*)(lds + 131072);
    const int wq0 = qb * 128 + qs * 32;
    const int tq = wq0 + l31;
    const size_t row = (size_t)b * 8192 + tq;
    bf16x8 qf[4];
#pragma unroll
    for (int ks = 0; ks < 4; ++ks) qf[ks] = *(const bf16x8*)(Q + row * 1024 + h * 128 + r * 64 + ks * 16 + hh * 8);
    const float kn2 = __uint_as_float(((const unsigned*)(p.ws + OFF_KN))[b * 8 + h]);
    float mref;
    {
        float ss = 0.f, dg = 0.f;
#pragma unroll
        for (int ks = 0; ks < 4; ++ks) {
            const bf16x8 kd = *(const bf16x8*)(Kg + ((size_t)(b * 8 + h) * 8192 + tq) * 128 + r * 64 + ks * 16 + hh * 8);
#pragma unroll
            for (int e = 0; e < 8; ++e) { const float v = bf2f((u16)qf[ks][e]); ss += v * v; dg += v * bf2f((u16)kd[e]); }
        }
        ss += __shfl_xor(ss, 32); dg += __shfl_xor(dg, 32);
        mref = 0.5f * (sqrtf(ss * kn2) * 1.001f + dg);
#pragma unroll
        for (int o = 16; o > 0; o >>= 1) { ss = fmaxf(ss, __shfl_xor(ss, o)); dg = fminf(dg, __shfl_xor(dg, o)); }
        if (lane == 0) { red[w] = ss; red[8 + w] = dg; }
    }
    __syncthreads();
    float qn2 = red[0], dmin = red[8];
#pragma unroll
    for (int i = 1; i < 8; ++i) { qn2 = fmaxf(qn2, red[i]); dmin = fminf(dmin, red[8 + i]); }
    const float ms = __builtin_bit_cast(float, __builtin_amdgcn_readfirstlane(__builtin_bit_cast(int, exp2f(-(float)(h + 1)) * LOG2E)));
    const float Dw = fminf((1.001f * sqrtf(qn2 * kn2) - dmin + 40.f) / ms, 1e6f);
    const float q0f = (float)(qb * 128);
    int lo = (int)floorf((q0f - 63.f - Dw) * (1.f / 64.f)) + 1; lo = lo < 0 ? 0 : lo;
    int hi = (int)ceilf((q0f + 127.f + Dw) * (1.f / 64.f)) - 1; hi = hi > 127 ? 127 : hi;
    lo = __builtin_amdgcn_readfirstlane(lo); hi = __builtin_amdgcn_readfirstlane(hi);
    f32x16 O[4];
#pragma unroll
    for (int e = 0; e < 4; ++e) O[e] = zero16();
    float lsum = 0.f;
    const u16* kbase = Kg + (size_t)(b * 8 + h) * 8192 * 128;
    const u16* vbase = VT + (size_t)((b * 8 + h) * 128) * 8192;
    unsigned ksrc[2], vsrc[2];
#pragma unroll
    for (int j = 0; j < 2; ++j) {
        const int piece = w * 2 + j;
        const int key = piece * 4 + (lane >> 4), kpos = lane & 15;
        ksrc[j] = (unsigned)(key * 128 + ((kpos ^ (key & 15)) * 8));
        const int ev = piece * 8 + (lane >> 3), vpos = lane & 7;
        vsrc[j] = (unsigned)(ev * 64 + ((vpos ^ ((ev >> 1) & 7)) * 8));
    }
#define ADMA(kt, buf) do { \
    _Pragma("unroll") for (int j_ = 0; j_ < 2; ++j_) { \
        __builtin_amdgcn_global_load_lds((const unsigned*)(kbase + (size_t)(kt) * 8192 + ksrc[j_]), (LAS unsigned*)(lds + (buf) * 32768 + (w * 2 + j_) * 1024), 16, 0, 0); \
        __builtin_amdgcn_global_load_lds((const unsigned*)(vbase + (size_t)(kt) * 8192 + vsrc[j_]), (LAS unsigned*)(lds + (buf) * 32768 + 16384 + (w * 2 + j_) * 1024), 16, 0, 0); } } while (0)
#define SB __builtin_amdgcn_sched_barrier(0)
    const unsigned kx = (unsigned)(l31 * 256 + (l31 & 15) * 16);
    const unsigned vx = (unsigned)(l31 * 128 + ((l31 >> 1) & 7) * 16);
    f32x16 s[2];
    bf16x8 vf[4];
#define EXP8(KB, H8) do { _Pragma("unroll") for (int i_ = 0; i_ < 8; ++i_) { const float pv_ = __builtin_amdgcn_exp2f(s[KB][(H8) * 8 + i_]); s[KB][(H8) * 8 + i_] = pv_; psum += pv_; } } while (0)
#define PVG(G4) do { const int kb_ = (G4) >> 1, s2_ = (G4) & 1; \
        const bf16x8 pfrag = pack8(s[kb_][8 * s2_], s[kb_][8 * s2_ + 1], s[kb_][8 * s2_ + 2], s[kb_][8 * s2_ + 3], s[kb_][8 * s2_ + 4], s[kb_][8 * s2_ + 5], s[kb_][8 * s2_ + 6], s[kb_][8 * s2_ + 7]); \
        SB; \
        _Pragma("unroll") for (int e = 0; e < 4; ++e) O[e] = MFMA(vf[e], pfrag, O[e]); \
        SB; \
        if ((G4) < 3) { _Pragma("unroll") for (int e = 0; e < 4; ++e) vf[e] = *(const bf16x8*)(vsm + e * 4096 + (vx ^ (unsigned)((((G4) + 1) * 2 + hh) * 16))); } \
        } while (0)
#define TILE_BODY(KT, SLOT) do { \
        const char* ksm = lds + (SLOT) * 32768; const char* vsm = ksm + 16384; \
        const int k0 = (KT) * 64; \
        const float dl2 = (float)(k0 + 4 * hh - tq); \
        bf16x8 kf[2][4]; \
        _Pragma("unroll") for (int kb = 0; kb < 2; ++kb) \
        _Pragma("unroll") for (int ks = 0; ks < 4; ++ks) kf[kb][ks] = *(const bf16x8*)(ksm + kb * 8192 + (kx ^ (unsigned)((r * 8 + ks * 2 + hh) * 16))); \
        SB; \
        if (k0 + 63 < wq0 || k0 > wq0 + 31) { \
            const float sm = (k0 + 63 < wq0) ? ms : -ms; \
            const float tl = sm * dl2 - mref; \
            _Pragma("unroll") for (int kb = 0; kb < 2; ++kb) \
            _Pragma("unroll") for (int i = 0; i < 16; ++i) s[kb][i] = __builtin_fmaf(sm, (float)(kb * 32 + (i & 3) + 8 * (i >> 2)), tl); \
        } else { \
            _Pragma("unroll") for (int kb = 0; kb < 2; ++kb) \
            _Pragma("unroll") for (int i = 0; i < 16; ++i) s[kb][i] = __builtin_fmaf(-ms, fabsf(dl2 + (float)(kb * 32 + (i & 3) + 8 * (i >> 2))), -mref); \
        } \
        SB; \
        _Pragma("unroll") for (int kb = 0; kb < 2; ++kb) \
        _Pragma("unroll") for (int ks = 0; ks < 4; ++ks) s[kb] = MFMA(kf[kb][ks], qf[ks], s[kb]); \
        _Pragma("unroll") for (int e = 0; e < 4; ++e) vf[e] = *(const bf16x8*)(vsm + e * 4096 + (vx ^ (unsigned)(hh * 16))); \
        SB; \
        float psum = 0.f; \
        EXP8(0, 0); EXP8(0, 1); \
        SB; \
        PVG(0); SB; EXP8(1, 0); SB; \
        PVG(1); SB; EXP8(1, 1); SB; \
        PVG(2); SB; \
        PVG(3); SB; \
        lsum += psum; \
    } while (0)
    ADMA(lo, 0);
    if (lo < hi) ADMA(lo + 1, 1);
    asm volatile("s_waitcnt vmcnt(0)" ::: "memory");
    __builtin_amdgcn_s_barrier();
    asm volatile("" ::: "memory");
    if (w >= 4) __builtin_amdgcn_s_setprio(1);
    int sb0 = 0;
    for (int kt = lo; kt <= hi; kt += 2) {
        const int nb0 = sb0 ^ 2;
        if (kt + 2 <= hi) ADMA(kt + 2, nb0);
        if (kt + 3 <= hi) ADMA(kt + 3, nb0 + 1);
        SB;
        TILE_BODY(kt, sb0);
        if (kt + 1 <= hi) TILE_BODY(kt + 1, sb0 + 1);
        asm volatile("s_waitcnt vmcnt(0)" ::: "memory");
        __builtin_amdgcn_s_barrier();
        asm volatile("" ::: "memory");
        sb0 = nb0;
    }
#undef TILE_BODY
#undef EXP8
#undef PVG
    __builtin_amdgcn_s_setprio(0);
    __syncthreads();
#undef ADMA
#undef SB
    lsum += __shfl_xor(lsum, 32);
    const float inv = 1.f / lsum;
    float* X = (float*)lds;
    if (r == 1) {
        const float sc = *(volatile float*)(lds + 131072 + 128) * inv;
#pragma unroll
        for (int e = 0; e < 4; ++e)
#pragma unroll
            for (int i = 0; i < 16; ++i) X[(qs * 64 + e * 16 + i) * 64 + lane] = O[e][i] * sc;
    }
    __syncthreads();
    if (r == 0) {
        float ss = 0.f;
#pragma unroll
        for (int e = 0; e < 4; ++e)
#pragma unroll
            for (int i = 0; i < 16; ++i) { const float o = O[e][i] * inv - X[(qs * 64 + e * 16 + i) * 64 + lane]; O[e][i] = o; ss += o * o; }
        ss += __shfl_xor(ss, 32);
        const float rstd = rsqrtf(ss * (1.f / 128.f) + 1e-5f) * 0.8f;
#pragma unroll
        for (int e = 0; e < 4; ++e)
#pragma unroll
            for (int grp = 0; grp < 4; ++grp) {
                const int ee = e * 32 + 8 * grp + 4 * hh;
                const u32x2 gg = *(const u32x2*)(G + row * 1024 + h * 128 + ee);
                const f32x4 sg = *(const f32x4*)(p.subln_g + ee);
                const float o0 = O[e][grp * 4 + 0] * rstd * sg[0] * siluf(bflo(gg.x));
                const float o1 = O[e][grp * 4 + 1] * rstd * sg[1] * siluf(bfhi(gg.x));
                const float o2 = O[e][grp * 4 + 2] * rstd * sg[2] * siluf(bflo(gg.y));
                const float o3 = O[e][grp * 4 + 3] * rstd * sg[3] * siluf(bfhi(gg.y));
                u32x2 ov; ov.x = pk2(o0, o1); ov.y = pk2(o2, o3);
                *(u32x2*)(Q + row * 1024 + h * 128 + ee) = ov;
            }
    }
    __syncthreads();
}

DI void phase_attn(const Params& p, char* lds, int wv) {
    const int tid = otid(wv), lane = tid & 63;
    const float d1 = wsum(p.lq1[lane] * p.lk1[lane]);
    const float d2 = wsum(p.lq2[lane] * p.lk2[lane]);
    if (tid == 0) *(volatile float*)(lds + 131072 + 128) = expf(d1) - expf(d2) + 0.2f;
    const float lam = 0.f;
    unsigned* ctr = (unsigned*)(p.ws + OFF_CTR);
    volatile int* s_item = (volatile int*)(lds + 131072 + 64);
    for (;;) {
        if (tid == 0) *s_item = (int)atomicAdd(ctr, 1u);
        __syncthreads();
        const int it = *s_item;
        if (it >= 1024) break;
        const int h = 7 - (it >> 7), b = (it >> 6) & 1, qb = it & 63;
        attn_item(p, b, h, qb, lam, lds, wv);
    }
}

DI void phase_gemm2(const Params& p, char* lds, int wv) {
    const pg8::Gemm g{(const u16*)(p.ws + OFF_Z), (const u16*)(p.ws + OFF_Q), (const u16*)(p.ws + OFF_WOT), M_TOK, 1024, 2048, 1024, 16};
    pg8::StaticOrder S; S.init(M_TOK, 1024, gridDim.x, blockIdx.x);
    pg8::gemm_phase<EpiOut, pg8::StaticOrder, true, true>((PG8_LAS unsigned char*)lds, g, S, EpiOut{(u16*)(p.ws + OFF_YL)}, wv);
}

DI void phase_ln_out(const Params& p, int wv) {
    const int tid = otid(wv), lane = tid & 63, w = __builtin_amdgcn_readfirstlane(tid >> 6);
    const int nwaves = gridDim.x * 8;
    f32x4 ge[4], be[4], g2[4], b2[4];
#pragma unroll
    for (int j = 0; j < 4; ++j) {
        ge[j] = *(const f32x4*)(p.ln_emb_g + j * 256 + lane * 4); be[j] = *(const f32x4*)(p.ln_emb_b + j * 256 + lane * 4);
        g2[j] = *(const f32x4*)(p.ln_g + j * 256 + lane * 4); b2[j] = *(const f32x4*)(p.ln_b + j * 256 + lane * 4);
    }
    int row = blockIdx.x * 8 + w;
    f32x4 xv[4]; u32x2 mv[4];
    const u16* MIX = (const u16*)(p.ws + OFF_YL);
    if (row < M_TOK) {
#pragma unroll
        for (int j = 0; j < 4; ++j) { xv[j] = __builtin_nontemporal_load((const f32x4*)(p.x + (size_t)row * 1024 + j * 256 + lane * 4)); mv[j] = __builtin_nontemporal_load((const u32x2*)(MIX + (size_t)row * 1024 + j * 256 + lane * 4)); }
    }
    for (; row < M_TOK; row += nwaves) {
        f32x4 xc[4], mc[4];
#pragma unroll
        for (int j = 0; j < 4; ++j) { xc[j] = xv[j]; mc[j][0] = bflo(mv[j].x); mc[j][1] = bfhi(mv[j].x); mc[j][2] = bflo(mv[j].y); mc[j][3] = bfhi(mv[j].y); }
        const int nrow = row + nwaves;
        if (nrow < M_TOK) {
#pragma unroll
            for (int j = 0; j < 4; ++j) { xv[j] = __builtin_nontemporal_load((const f32x4*)(p.x + (size_t)nrow * 1024 + j * 256 + lane * 4)); mv[j] = __builtin_nontemporal_load((const u32x2*)(MIX + (size_t)nrow * 1024 + j * 256 + lane * 4)); }
        }
        float s = 0.f;
#pragma unroll
        for (int j = 0; j < 4; ++j) s += xc[j][0] + xc[j][1] + xc[j][2] + xc[j][3];
        s = wsum(s);
        const float mean = s * (1.f / 1024.f);
        float q = 0.f;
#pragma unroll
        for (int j = 0; j < 4; ++j)
#pragma unroll
            for (int e = 0; e < 4; ++e) { const float d = xc[j][e] - mean; q += d * d; }
        q = wsum(q);
        const float rstd = rsqrtf(q * (1.f / 1024.f) + 1e-5f);
        float s2 = 0.f;
#pragma unroll
        for (int j = 0; j < 4; ++j)
#pragma unroll
            for (int e = 0; e < 4; ++e) { const float v = ALPHA_DN * ((xc[j][e] - mean) * rstd * ge[j][e] + be[j][e]) + mc[j][e]; mc[j][e] = v; s2 += v; }
        s2 = wsum(s2);
        const float mean2 = s2 * (1.f / 1024.f);
        float q2 = 0.f;
#pragma unroll
        for (int j = 0; j < 4; ++j)
#pragma unroll
            for (int e = 0; e < 4; ++e) { const float d = mc[j][e] - mean2; q2 += d * d; }
        q2 = wsum(q2);
        const float rstd2 = rsqrtf(q2 * (1.f / 1024.f) + 1e-5f);
#pragma unroll
        for (int j = 0; j < 4; ++j) {
            f32x4 h;
#pragma unroll
            for (int e = 0; e < 4; ++e) h[e] = (mc[j][e] - mean2) * rstd2 * g2[j][e] + b2[j][e];
            __builtin_nontemporal_store(h, (f32x4*)(p.out + (size_t)row * 1024 + j * 256 + lane * 4));
        }
    }
}

__global__ void __launch_bounds__(512) hybrid_fwd(Params p) {
    extern __shared__ __attribute__((aligned(16))) char lds[];
    cg::grid_group grid = cg::this_grid();
    const int wv = __builtin_amdgcn_readfirstlane((int)(threadIdx.x >> 6));
#define GBAR() do { XcdBarrier b_; b_.bar = (unsigned*)(p.ws + OFF_BAR); b_.x = xb_xcc_id(); b_.st = (volatile LAS unsigned*)(lds + LDS_BYTES - 16); xcd_barrier(b_, otid(wv) == 0); } while (0)
    if (threadIdx.x == 0) { volatile LAS unsigned* xst = (volatile LAS unsigned*)(lds + LDS_BYTES - 16); xst[0] = 0u; xst[1] = 0u; }
    phase_prep(p, lds, wv);
    grid.sync();
    (void)xcd_barrier_post((unsigned*)(p.ws + OFF_BAR), (volatile LAS unsigned*)(lds + LDS_BYTES - 16), otid(wv) == 0);
    phase_gemm1(p, lds, wv);
    GBAR();
    for (int it = blockIdx.x; it < 256; it += gridDim.x) ssdA_item(p, it, lds, wv);
    GBAR();
    phase_scan(p, wv);
    GBAR();
    for (int it = blockIdx.x; it < 256; it += gridDim.x) ssdC_item(p, it, lds, wv);
    phase_attn(p, lds, wv);
    GBAR();
    phase_gemm2(p, lds, wv);
    GBAR();
    phase_ln_out(p, wv);
#undef GBAR
}

extern "C" void kernel_launch(void* const* d_in, const int* in_sizes, int n_in, void* d_out, int out_size, void* d_ws, size_t ws_size,
                              hipStream_t stream) {
    static int grid_blocks = 0;
    if (!grid_blocks) {
        int dev = 0, cus = 0, per_cu = 0;
        hipGetDevice(&dev);
        hipDeviceGetAttribute(&cus, hipDeviceAttributeMultiprocessorCount, dev);
        hipFuncSetAttribute((const void*)hybrid_fwd, hipFuncAttributeMaxDynamicSharedMemorySize, LDS_BYTES);
        hipOccupancyMaxActiveBlocksPerMultiprocessor(&per_cu, hybrid_fwd, 512, LDS_BYTES);
        if (per_cu > 1) per_cu = 1;
        grid_blocks = cus * per_cu;
        if (grid_blocks <= 0) grid_blocks = 256;
    }
    if (ws_size < WS_NEED) { fprintf(stderr, "workspace too small: %zu < %zu\n", ws_size, (size_t)WS_NEED); return; }
    Params p{};
    const float** f = (const float**)&p;
    for (int i = 0; i < 20; ++i) f[i] = (const float*)d_in[i];
    p.out = (float*)d_out;
    p.ws = (char*)d_ws;
    void* args[] = {&p};
    hipError_t e = hipLaunchCooperativeKernel((const void*)hybrid_fwd, dim3(grid_blocks), dim3(512), args, LDS_BYTES, stream);
    if (e != hipSuccess) fprintf(stderr, "cooperative launch failed: %s (grid %d)\n", hipGetErrorString(e), grid_blocks);
}
```

```cpp
#include <hip/hip_runtime.h>
#include <hip/hip_cooperative_groups.h>
#include <cstdio>
#include <cstdint>
namespace cg = cooperative_groups;

#define DI __device__ __forceinline__
typedef unsigned short u16;
typedef short bf16x8 __attribute__((ext_vector_type(8)));
typedef short bf16x4 __attribute__((ext_vector_type(4)));
typedef float f32x16 __attribute__((ext_vector_type(16)));
typedef float f32x4 __attribute__((ext_vector_type(4)));
typedef float f32x2 __attribute__((ext_vector_type(2)));
typedef __bf16 bf2_t __attribute__((ext_vector_type(2)));
typedef unsigned u32x4 __attribute__((ext_vector_type(4)));
typedef unsigned u32x2 __attribute__((ext_vector_type(2)));
#define MFMA(a, b, c) __builtin_amdgcn_mfma_f32_32x32x16_bf16((a), (b), (c), 0, 0, 0)

constexpr int M_TOK = 16384;
constexpr float LOG2E = 1.4426950408889634f;
constexpr float ALPHA_DN = 1.189207115002721f;

constexpr size_t SZ_ACT = (size_t)M_TOK * 1024 * 2;
constexpr size_t OFF_Z = 0;
constexpr size_t OFF_XBC = OFF_Z + SZ_ACT;
constexpr size_t OFF_Q = OFF_XBC + (size_t)M_TOK * 1536 * 2;
constexpr size_t OFF_K = OFF_Q + SZ_ACT;
constexpr size_t OFF_VT = OFF_K + SZ_ACT;
constexpr size_t OFF_G = OFF_VT + SZ_ACT;
constexpr size_t OFF_YL = OFF_G + SZ_ACT;
constexpr size_t OFF_DT = OFF_YL + SZ_ACT;
constexpr size_t OFF_EA = OFF_DT + (size_t)M_TOK * 32 * 4;
constexpr size_t OFF_WOT = OFF_EA + (size_t)M_TOK * 32 * 4;
constexpr size_t OFF_STATS = OFF_WOT + (size_t)1024 * 2048 * 2;
constexpr size_t OFF_DEC = OFF_STATS + (size_t)M_TOK * 2 * 4;
constexpr size_t OFF_KN = OFF_DEC + (size_t)2 * 16 * 2 * 64 * 4;
constexpr size_t OFF_CTR = OFF_KN + 256;
constexpr size_t OFF_BAR = OFF_CTR + 256;
constexpr size_t WS_NEED = OFF_BAR + 16384;
constexpr int LDS_BYTES = 153616;

struct Params {
    const float *x, *ln_emb_g, *ln_emb_b, *w_in, *conv_w, *conv_b, *A_log_f, *A_log_b, *dt_bias_f, *dt_bias_b, *D,
        *ssm_norm_g, *lq1, *lk1, *lq2, *lk2, *subln_g, *w_out, *ln_g, *ln_b;
    float* out;
    char* ws;
};

DI unsigned pk2(float lo, float hi) { f32x2 v = {lo, hi}; bf2_t b = __builtin_convertvector(v, bf2_t); return __builtin_bit_cast(unsigned, b); }
DI u16 tobf(float x) { return (u16)(pk2(x, 0.f) & 0xffffu); }
DI float bf2f(u16 v) { return __uint_as_float(((unsigned)v) << 16); }
DI float bflo(unsigned u) { return __uint_as_float(u << 16); }
DI float bfhi(unsigned u) { return __uint_as_float(u & 0xffff0000u); }
DI float wsum(float v) {
#pragma unroll
    for (int o = 32; o > 0; o >>= 1) v += __shfl_xor(v, o);
    return v;
}
DI float siluf(float v) { return v / (1.f + __expf(-v)); }
DI float softplusf(float x) { return x > 20.f ? x : log1pf(expf(x)); }
DI int otid(int wv) { int t = wv * 64 + (int)__builtin_amdgcn_mbcnt_hi(~0u, __builtin_amdgcn_mbcnt_lo(~0u, 0u)); asm volatile("" : "+v"(t)); return t; }
DI int crow(int i, int hh) { return (i & 3) + 8 * (i >> 2) + 4 * hh; }
DI bf16x8 pack8(float a0, float a1, float a2, float a3, float a4, float a5, float a6, float a7) {
    u32x4 p; p.x = pk2(a0, a1); p.y = pk2(a2, a3); p.z = pk2(a4, a5); p.w = pk2(a6, a7);
    return __builtin_bit_cast(bf16x8, p);
}
DI f32x16 zero16() { f32x16 z;
#pragma unroll
    for (int i = 0; i < 16; ++i) z[i] = 0.f;
    return z; }

#define XB_TMO      128
#define XB_XCNT(j)  (256  + 64 * (j))
#define XB_XSUB(j)  (1280 + 64 * (j))
#define XB_XGEN(j)  (2304 + 64 * (j))
#define XB_TOP      3328
#define XB_TOPGEN   3392
#define XCD_BAR_WORDS 3456
#define XB_SPIN_CAP (1u << 18)
#define LAS __attribute__((address_space(3)))

__device__ __forceinline__ unsigned xb_ld(unsigned* p)              { return __hip_atomic_load(p, __ATOMIC_RELAXED, __HIP_MEMORY_SCOPE_AGENT); }
__device__ __forceinline__ unsigned xb_add(unsigned* p, unsigned v) { return __hip_atomic_fetch_add(p, v, __ATOMIC_RELAXED, __HIP_MEMORY_SCOPE_AGENT); }
__device__ __forceinline__ unsigned xb_xcc_id() { return (unsigned)__builtin_amdgcn_s_getreg((3 << 11) | 20) & 0xFu; }
#define XB_SPIN(cond, bar) do { unsigned _sp = 0; while (cond) { __builtin_amdgcn_s_sleep(1); \
    if ((++_sp & 255u) == 0u) { if (xb_ld(&(bar)[XB_TMO])) break; if (_sp > XB_SPIN_CAP) { atomicAdd(&(bar)[XB_TMO], 1u); break; } } } } while (0)

struct XcdBarrier {
    unsigned* bar; unsigned x;
    volatile LAS unsigned* st;
};

__device__ __forceinline__ XcdBarrier xcd_barrier_post(unsigned* bar, volatile LAS unsigned* st, bool leader) {
    XcdBarrier b; b.bar = bar; b.x = xb_xcc_id(); b.st = st;
    if (leader) (void)xb_add(&bar[XB_XCNT(b.x)], 1u);
    return b;
}
__device__ __forceinline__ void xcd_barrier_complete(unsigned* bar, unsigned x, unsigned& nloc, unsigned& nx) {
    const unsigned G = gridDim.x * gridDim.y * gridDim.z;
    unsigned sum, cnt, mine, sp = 0u;
    for (;;) {
        sum = 0u; cnt = 0u; mine = 0u;
#pragma unroll
        for (unsigned j = 0; j < 16; ++j) { const unsigned c = xb_ld(&bar[XB_XCNT(j)]); sum += c; cnt += (c > 0u) ? 1u : 0u; mine = (j == x) ? c : mine; }
        if (sum == G) break;
        __builtin_amdgcn_s_sleep(1);
        if ((++sp & 255u) == 0u) { if (xb_ld(&bar[XB_TMO])) break; if (sp > XB_SPIN_CAP) { atomicAdd(&bar[XB_TMO], 1u); break; } }
    }
    nloc = mine > 0u ? mine : 1u; nx = cnt > 0u ? cnt : 1u;
}

__device__ __forceinline__ void xcd_barrier(const XcdBarrier& b, bool leader) {
    asm volatile("s_waitcnt vmcnt(0)" ::: "memory");
    __syncthreads();
    if (leader) {
        unsigned* bar = b.bar;
        __builtin_amdgcn_s_waitcnt(0);
        unsigned nloc = b.st[0], nx = b.st[1];
        if (nloc == 0u) { xcd_barrier_complete(bar, b.x, nloc, nx); b.st[0] = nloc; b.st[1] = nx; }
        const unsigned old = xb_add(&bar[XB_XSUB(b.x)], 1u);
        const unsigned gen = old / nloc;
        if (old + 1u == (gen + 1u) * nloc) {
            __builtin_amdgcn_fence(__ATOMIC_RELEASE, "agent");
            asm volatile("s_waitcnt vmcnt(0)" ::: "memory");
            const unsigned og = xb_add(&bar[XB_TOP], 1u);
            const unsigned tg = og / nx;
            if (og + 1u == (tg + 1u) * nx) xb_add(&bar[XB_TOPGEN], 1u);
            else XB_SPIN(xb_ld(&bar[XB_TOPGEN]) == tg, bar);
            __builtin_amdgcn_fence(__ATOMIC_ACQUIRE, "agent");
            xb_add(&bar[XB_XGEN(b.x)], 1u);
            asm volatile("s_waitcnt vmcnt(0)" ::: "memory");
        } else {
            XB_SPIN(xb_ld(&bar[XB_XGEN(b.x)]) == gen, bar);
            __builtin_amdgcn_fence(__ATOMIC_ACQUIRE, "agent");
            asm volatile("s_waitcnt vmcnt(0)" ::: "memory");
        }
    }
    __syncthreads();
}


DI void phase_prep(const Params& p, char* lds, int wv) {
    const int tid = otid(wv), lane = tid & 63, w = __builtin_amdgcn_readfirstlane(tid >> 6);
    u16* HB = (u16*)p.out;
    u16* WIT = HB + (size_t)M_TOK * 1024;
    u16* WOT = (u16*)(p.ws + OFF_WOT);
    const int nwaves = gridDim.x * 8;
    {
        f32x4 g4[4], b4[4], nx[4];
#pragma unroll
        for (int j = 0; j < 4; ++j) { g4[j] = *(const f32x4*)(p.ln_emb_g + j * 256 + lane * 4); b4[j] = *(const f32x4*)(p.ln_emb_b + j * 256 + lane * 4); }
        int row = blockIdx.x * 8 + w;
        if (row < M_TOK) {
#pragma unroll
            for (int j = 0; j < 4; ++j) nx[j] = __builtin_nontemporal_load((const f32x4*)(p.x + (size_t)row * 1024 + j * 256 + lane * 4));
        }
        for (; row < M_TOK; row += nwaves) {
            f32x4 v[4];
#pragma unroll
            for (int j = 0; j < 4; ++j) v[j] = nx[j];
            if (row + nwaves < M_TOK) {
#pragma unroll
                for (int j = 0; j < 4; ++j) nx[j] = __builtin_nontemporal_load((const f32x4*)(p.x + (size_t)(row + nwaves) * 1024 + j * 256 + lane * 4));
            }
            float s = 0.f;
#pragma unroll
            for (int j = 0; j < 4; ++j) s += v[j][0] + v[j][1] + v[j][2] + v[j][3];
            s = wsum(s);
            const float mean = s * (1.f / 1024.f);
            float q = 0.f;
#pragma unroll
            for (int j = 0; j < 4; ++j)
#pragma unroll
                for (int e = 0; e < 4; ++e) { float d = v[j][e] - mean; q += d * d; }
            q = wsum(q);
            const float rstd = rsqrtf(q * (1.f / 1024.f) + 1e-5f);
#pragma unroll
            for (int j = 0; j < 4; ++j) {
                f32x4 h;
#pragma unroll
                for (int e = 0; e < 4; ++e) h[e] = (v[j][e] - mean) * rstd * g4[j][e] + b4[j][e];
                u32x2 o; o.x = pk2(h[0], h[1]); o.y = pk2(h[2], h[3]);
                *(u32x2*)(HB + (size_t)row * 1024 + j * 256 + lane * 4) = o;
            }
        }
    }
    u16* T = (u16*)lds;
    const int n_tiles_in = 105 * 16, n_tiles_out = 16 * 32;
    for (int t = blockIdx.x; t < n_tiles_in + n_tiles_out; t += gridDim.x) {
        const float* W; int ldw, nsrc, k0, n0, ldd; u16* dst; bool isin = t < n_tiles_in;
        if (isin) { W = p.w_in; ldw = 6688; nsrc = 6688; k0 = (t & 15) * 64; n0 = (t >> 4) * 64; dst = WIT; ldd = 1024; }
        else { int u = t - n_tiles_in; W = p.w_out; ldw = 1024; nsrc = 1024; k0 = (u & 31) * 64; n0 = (u >> 5) * 64; dst = WOT; ldd = 2048; }
#pragma unroll
        for (int i = 0; i < 2; ++i) {
            const int e = tid + 512 * i, k = e >> 4, n4 = (e & 15) * 4;
            f32x4 v = {0.f, 0.f, 0.f, 0.f};
            if (n0 + n4 < nsrc) v = __builtin_nontemporal_load((const f32x4*)(W + (size_t)(k0 + k) * ldw + n0 + n4));
#pragma unroll
            for (int q = 0; q < 4; ++q) T[(n4 + q) * 66 + k] = tobf(v[q]);
        }
        __syncthreads();
        {
            const int n = tid >> 3, kc = (tid & 7) * 8, ns = n0 + n;
            if (ns < nsrc) {
                int nd = ns;
                if (isin) nd = (ns < 2560) ? ns : (ns < 2592) ? (ns + 3072) : (ns < 4640) ? (ns - 32) : (ns < 5664) ? (ns + 1248) : (ns - 1056);
                const unsigned* tp = (const unsigned*)(T + n * 66 + kc);
                u32x4 o; o.x = tp[0]; o.y = tp[1]; o.z = tp[2]; o.w = tp[3];
                *(u32x4*)(dst + (size_t)nd * ldd + k0 + kc) = o;
            }
        }
        __syncthreads();
    }
    if (blockIdx.x == 0) { if (tid < 128) ((unsigned*)(p.ws + OFF_KN))[tid] = 0u;
        for (int e = tid; e < 4096; e += 512) ((unsigned*)(p.ws + OFF_BAR))[e] = 0u; }
    for (int e = blockIdx.x * 512 + tid; e < 224 * 512; e += gridDim.x * 512) ((unsigned*)(WIT + (size_t)5664 * 1024))[e] = 0u;
}

namespace pg8 {
#define PG8_LAS __attribute__((address_space(3)))
typedef unsigned short bf16_t;
typedef short bf16x8 __attribute__((ext_vector_type(8)));
typedef float f32x4 __attribute__((ext_vector_type(4)));
typedef unsigned u32x4 __attribute__((ext_vector_type(4)));
constexpr int BM = 256, BK = 64, HALF = 128, HTB = HALF * BK * 2  , STAGE_BYTES = 8 * HTB, NXCD = 8, WGM = 8;

__host__ __device__ __forceinline__ int lds_byte(int r, int c) { const int st = (r >> 4) * 2 + (c >> 5), rr = r & 15, cc = c & 31, ob = rr * 64 + cc * 2; return st * 1024 + (ob ^ (((ob >> 9) & 1) << 5)); }
__host__ __device__ __forceinline__ void stage_rc(int b, int& R, int& C) { const int st = b / 1024, sb = b % 1024, swz = sb ^ (((sb >> 9) & 1) << 5); R = (st >> 1) * 16 + swz / 64; C = (st & 1) * 32 + (swz % 64) / 2; }
__host__ __device__ __forceinline__ int perm32(int rho) { const int n = rho >> 4, i = rho & 15; return 8 * (i >> 2) + 4 * n + (i & 3); }

struct Unit { int pm, pn; };
struct Gemm { const bf16_t* A; const bf16_t* A1; const bf16_t* Bt; int M, N, K, lda, ksplit; };

struct StaticOrder {
    int nM, nN, nwg, G, c;
    __host__ __device__ void init(int M, int N, int G_, int c_) { nM = M / BM; nN = N / BM; nwg = nM * nN; G = G_; c = c_; }
    __host__ __device__ bool next(int i, Unit& u) const {
        const long L = (long)i * G + c; if (L >= nwg) return false;
        int wgid = (int)L; { const int q = nwg / NXCD, r = nwg % NXCD, xcd = wgid % NXCD, off = wgid / NXCD; wgid = (xcd < r ? xcd * (q + 1) : r * (q + 1) + (xcd - r) * q) + off; }
        const int nig = WGM * nN, gid = wgid / nig, fm = gid * WGM, gsz = (nM - fm) < WGM ? (nM - fm) : WGM;
        u.pm = fm + ((wgid % nig) % gsz); u.pn = (wgid % nig) / gsz; return true;
    }
    __device__ __forceinline__ void a_ready(const Unit&) const {}
    __device__ __forceinline__ void done(const Unit&) const {}
};
template <class Epi, class Sched, bool ALIGN_EPI = false, bool SP2 = false>
__device__ __forceinline__ void gemm_phase(PG8_LAS unsigned char* lds, const Gemm g, const Sched& S, const Epi& E, int wv) {
    const int tid = otid(wv), wid = __builtin_amdgcn_readfirstlane(tid >> 6), lane = tid & 63, wr = wid >> 2, wc = wid & 3, fr = lane & 15, fq = lane >> 4;
    const int K = g.K, nt = K / BK;
    unsigned voffA[2], voffB[2];
#pragma unroll
    for (int i = 0; i < 2; ++i) { int R, C; stage_rc(tid * 16 + i * 8192, R, C); const int Rb = Epi::PERM ? ((R & ~31) + perm32(R & 31)) : R;
        voffA[i] = (unsigned)(R * g.lda + C) * 2u; voffB[i] = (unsigned)(Rb * K + C) * 2u; }
    const size_t kstep = (size_t)(BK * 2);
    const size_t hstep = (size_t)HALF * K * 2;
    const size_t tstep = 2 * hstep;
    const size_t hstepA = (size_t)HALF * g.lda * 2, tstepA = 2 * hstepA;
    const int ksp = g.ksplit;
#define PG8_AP(b0, b1, t_) (((t_) < ksp) ? ((b0) + (size_t)(t_) * kstep) : ((b1) + (size_t)((t_) - ksp) * kstep))
    const unsigned ldsw = (unsigned)wid * 1024u;
    const int aoff = lds_byte(wr * 64 + fr, fq * 8), boff = lds_byte(wc * 32 + fr, fq * 8);
#define PG8_SA(b, h) (((b) * 2 + (h)) * HTB)
#define PG8_SB(b, h) ((4 + (b) * 2 + (h)) * HTB)
#define PG8_STAGE(bufoff, gbase, voff) do { _Pragma("unroll") for (int _i = 0; _i < 2; ++_i) \
        __builtin_amdgcn_global_load_lds((const unsigned*)((const char*)(gbase) + (voff)[_i]), (PG8_LAS unsigned*)(lds + (bufoff) + ldsw + _i * 8192), 16, 0, 0); } while (0)
#define PG8_LDA(dst, b, h) do { _Pragma("unroll") for (int m = 0; m < 4; ++m) _Pragma("unroll") for (int k = 0; k < 2; ++k) dst[m][k] = *(const PG8_LAS bf16x8*)(lds + PG8_SA(b, h) + aoff + m * 2048 + k * 1024); } while (0)
#define PG8_LDB(dst, b, h) do { _Pragma("unroll") for (int n = 0; n < 2; ++n) _Pragma("unroll") for (int k = 0; k < 2; ++k) dst[n][k] = *(const PG8_LAS bf16x8*)(lds + PG8_SB(b, h) + boff + n * 2048 + k * 1024); } while (0)
#define PG8_MMA(ai, bj, At, Bt) do { __builtin_amdgcn_s_setprio(1); _Pragma("unroll") for (int m = 0; m < 4; ++m) _Pragma("unroll") for (int n = 0; n < 2; ++n) _Pragma("unroll") for (int k = 0; k < 2; ++k) \
        acc[ai][bj][m][n] = __builtin_amdgcn_mfma_f32_16x16x32_bf16(Bt[n][k], At[m][k], acc[ai][bj][m][n], 0, 0, 0); __builtin_amdgcn_s_setprio(0); } while (0)
#define PG8_WAIT_V(n) asm volatile("s_waitcnt vmcnt(" #n ")" ::: "memory")
#define PG8_WAIT_L(n) asm volatile("s_waitcnt lgkmcnt(" #n ")" ::: "memory")
#define PG8_BAR __builtin_amdgcn_s_barrier()
#define PG8_SCHED __builtin_amdgcn_sched_barrier(0)
    Unit cur, nxt; int ui = 0;
    if (!S.next(0, cur)) return;
    f32x4 acc[2][2][4][2];
#pragma unroll
    for (int a = 0; a < 2; ++a)
#pragma unroll
        for (int b = 0; b < 2; ++b)
#pragma unroll
            for (int m = 0; m < 4; ++m)
#pragma unroll
                for (int n = 0; n < 2; ++n) acc[a][b][m][n] = (f32x4){0.f, 0.f, 0.f, 0.f};
    bf16x8 At[4][2], B0[2][2], B1[2][2];
    const char* cA = (const char*)g.A + (size_t)cur.pm * tstepA; const char* cA1 = (const char*)g.A1 + (size_t)cur.pm * tstepA; const char* cB = (const char*)g.Bt + (size_t)cur.pn * tstep;
    S.a_ready(cur);
    if constexpr (SP2) {
        PG8_STAGE(PG8_SB(0, 0), cB, voffB); PG8_STAGE(PG8_SB(0, 1), cB + hstep, voffB); PG8_STAGE(PG8_SA(0, 0), cA, voffA); PG8_STAGE(PG8_SA(0, 1), cA + hstepA, voffA);
        if (wr == 1) PG8_BAR;
        PG8_WAIT_V(2); PG8_BAR;
        PG8_STAGE(PG8_SB(1, 0), cB + kstep, voffB); PG8_STAGE(PG8_SA(1, 0), PG8_AP(cA, cA1, 1), voffA); PG8_STAGE(PG8_SB(1, 1), cB + hstep + kstep, voffB);
        PG8_WAIT_V(6); PG8_BAR;
    } else {
        PG8_STAGE(PG8_SB(0, 0), cB, voffB); PG8_STAGE(PG8_SA(0, 0), cA, voffA); PG8_STAGE(PG8_SB(0, 1), cB + hstep, voffB); PG8_STAGE(PG8_SA(0, 1), cA + hstepA, voffA);
        if (wr == 1) PG8_BAR;
        PG8_WAIT_V(4); PG8_BAR;
        PG8_STAGE(PG8_SB(1, 0), cB + kstep, voffB); PG8_STAGE(PG8_SA(1, 0), PG8_AP(cA, cA1, 1), voffA); PG8_STAGE(PG8_SB(1, 1), cB + hstep + kstep, voffB);
        PG8_WAIT_V(6); PG8_BAR;
    }
    for (;;) {
        const bool has_next = S.next(ui + 1, nxt);
        const char* nA = has_next ? (const char*)g.A + (size_t)nxt.pm * tstepA : cA; const char* nA1 = has_next ? (const char*)g.A1 + (size_t)nxt.pm * tstepA : cA1; const char* nB = has_next ? (const char*)g.Bt + (size_t)nxt.pn * tstep : cB;
        for (int t = 0; t < nt; t += 2) {
            const bool last = (t == nt - 2);
            const char* a1 = PG8_AP(cA, cA1, t + 1);
            const char* a2 = last ? nA : PG8_AP(cA, cA1, t + 2); const char* b2 = last ? nB : cB + (size_t)(t + 2) * kstep;
            const char* a3 = a2 + kstep; const char* b3 = b2 + kstep;
            if (last && has_next) S.a_ready(nxt);
            if constexpr (SP2) {
            PG8_LDB(B0, 0, 0); PG8_LDB(B1, 0, 1); PG8_SCHED; PG8_LDA(At, 0, 0); PG8_STAGE(PG8_SA(1, 1), a1 + hstepA, voffA);
            PG8_WAIT_V(8); PG8_WAIT_L(0); PG8_BAR; PG8_MMA(0, 0, At, B0); PG8_MMA(0, 1, At, B1); PG8_BAR; PG8_SCHED;
            PG8_LDA(At, 0, 1); PG8_STAGE(PG8_SB(0, 0), b2, voffB); PG8_STAGE(PG8_SB(0, 1), b2 + hstep, voffB); PG8_STAGE(PG8_SA(0, 0), a2, voffA);
            PG8_WAIT_V(8); PG8_WAIT_L(0); PG8_BAR; PG8_MMA(1, 0, At, B0); PG8_MMA(1, 1, At, B1); PG8_BAR; PG8_SCHED;
            PG8_LDB(B0, 1, 0); PG8_LDB(B1, 1, 1); PG8_SCHED; PG8_LDA(At, 1, 0); PG8_STAGE(PG8_SA(0, 1), a2 + hstepA, voffA);
            PG8_WAIT_V(8); PG8_WAIT_L(0); PG8_BAR; PG8_MMA(0, 0, At, B0); PG8_MMA(0, 1, At, B1); PG8_BAR; PG8_SCHED;
            PG8_LDA(At, 1, 1); PG8_STAGE(PG8_SB(1, 0), b3, voffB); PG8_STAGE(PG8_SB(1, 1), b3 + hstep, voffB); PG8_STAGE(PG8_SA(1, 0), a3, voffA);
            PG8_WAIT_V(8); PG8_WAIT_L(0); PG8_BAR; PG8_MMA(1, 0, At, B0); PG8_MMA(1, 1, At, B1); PG8_BAR; PG8_SCHED;
            } else {
            PG8_LDB(B0, 0, 0); PG8_SCHED; PG8_LDA(At, 0, 0); PG8_STAGE(PG8_SA(1, 1), a1 + hstepA, voffA);
            PG8_WAIT_L(8); PG8_BAR; PG8_WAIT_L(0); PG8_MMA(0, 0, At, B0); PG8_BAR; PG8_SCHED;
            PG8_LDB(B1, 0, 1); PG8_STAGE(PG8_SB(0, 0), b2, voffB);
            PG8_BAR; PG8_WAIT_L(0); PG8_MMA(0, 1, At, B1); PG8_BAR;
            PG8_LDA(At, 0, 1); PG8_STAGE(PG8_SA(0, 0), a2, voffA);
            PG8_BAR; PG8_WAIT_L(0); PG8_MMA(1, 0, At, B0); PG8_BAR; PG8_SCHED;
            PG8_STAGE(PG8_SB(0, 1), b2 + hstep, voffB);
            PG8_WAIT_V(6); PG8_BAR; PG8_MMA(1, 1, At, B1); PG8_BAR;
            PG8_LDB(B0, 1, 0); PG8_SCHED; PG8_LDA(At, 1, 0); PG8_STAGE(PG8_SA(0, 1), a2 + hstepA, voffA);
            PG8_WAIT_L(8); PG8_BAR; PG8_WAIT_L(0); PG8_MMA(0, 0, At, B0); PG8_BAR; PG8_SCHED;
            PG8_LDB(B1, 1, 1); PG8_STAGE(PG8_SB(1, 0), b3, voffB);
            PG8_BAR; PG8_WAIT_L(0); PG8_MMA(0, 1, At, B1); PG8_BAR;
            PG8_LDA(At, 1, 1); PG8_STAGE(PG8_SA(1, 0), a3, voffA);
            PG8_BAR; PG8_WAIT_L(0); PG8_MMA(1, 0, At, B0); PG8_BAR; PG8_SCHED;
            PG8_STAGE(PG8_SB(1, 1), b3 + hstep, voffB);
            PG8_WAIT_V(6); PG8_BAR; PG8_MMA(1, 1, At, B1); PG8_BAR;
            }
        }
        if constexpr (ALIGN_EPI) { if (wr == 0) PG8_BAR; }
        if constexpr (!Epi::AFTER_DRAIN) { E(acc, cur, wr, wc, fr, fq); S.done(cur); }
        if (!has_next) break;
#pragma unroll
        for (int a = 0; a < 2; ++a)
#pragma unroll
            for (int b = 0; b < 2; ++b)
#pragma unroll
                for (int m = 0; m < 4; ++m)
#pragma unroll
                    for (int n = 0; n < 2; ++n) acc[a][b][m][n] = (f32x4){0.f, 0.f, 0.f, 0.f};
        cur = nxt; cA = nA; cA1 = nA1; cB = nB; ++ui;
        if constexpr (ALIGN_EPI) { if (wr == 1) PG8_BAR; }
    }
    PG8_WAIT_V(0);
    if constexpr (!ALIGN_EPI) { if (wr == 0) PG8_BAR; }
    PG8_BAR;
    if constexpr (Epi::AFTER_DRAIN) { E.fused(acc, cur, wr, wc, fr, fq, lds, wid, lane); S.done(cur); }
#undef PG8_AP
#undef PG8_SA
#undef PG8_SB
#undef PG8_STAGE
#undef PG8_LDA
#undef PG8_LDB
#undef PG8_MMA
#undef PG8_WAIT_V
#undef PG8_WAIT_L
#undef PG8_BAR
#undef PG8_SCHED
}
}


struct EpiProj {
    static constexpr bool PERM = true, AFTER_DRAIN = false;
    char* ws;
    DI void operator()(const pg8::f32x4 (&acc)[2][2][4][2], const pg8::Unit& u, int wr, int wc, int fr, int fq) const {
        const int pn = u.pn, row0 = u.pm * 256 + wr * 64 + fr;
        if (pn < 22) {
            u16* dst; int ld, cb; float sc = 1.f; const bool isk = (pn >= 14 && pn < 18);
            if (pn < 4) { dst = (u16*)(ws + OFF_Z); ld = 1024; cb = pn * 256; }
            else if (pn < 10) { dst = (u16*)(ws + OFF_XBC); ld = 1536; cb = (pn - 4) * 256; }
            else if (pn < 14) { dst = (u16*)(ws + OFF_Q); ld = 1024; cb = (pn - 10) * 256; sc = 0.125f * LOG2E; }
            else if (pn < 18) { dst = (u16*)(ws + OFF_K); ld = 128; cb = 0; }
            else { dst = (u16*)(ws + OFF_G); ld = 1024; cb = (pn - 18) * 256; }
#pragma unroll
            for (int ai = 0; ai < 2; ++ai)
#pragma unroll
                for (int m = 0; m < 4; ++m) {
                    const int r = row0 + ai * 128 + m * 16;
#pragma unroll
                    for (int bj = 0; bj < 2; ++bj) {
                        const size_t rowaddr = isk ? ((size_t)((r >> 13) * 8 + (pn - 14) * 2 + bj) * 8192 + (r & 8191)) : (size_t)r;
                        const int col = isk ? (wc * 32 + 8 * fq) : (cb + bj * 128 + wc * 32 + 8 * fq);
                        const pg8::f32x4 v0 = acc[ai][bj][m][0], v1 = acc[ai][bj][m][1];
                        u32x4 wv4; wv4.x = pk2(v0[0] * sc, v0[1] * sc); wv4.y = pk2(v0[2] * sc, v0[3] * sc); wv4.z = pk2(v1[0] * sc, v1[1] * sc); wv4.w = pk2(v1[2] * sc, v1[3] * sc);
                        __builtin_nontemporal_store(wv4, (u32x4*)(dst + rowaddr * ld + col));
                    }
                }
        } else if (wc == 0) {
            float* DT = (float*)(ws + OFF_DT);
#pragma unroll
            for (int ai = 0; ai < 2; ++ai)
#pragma unroll
                for (int m = 0; m < 4; ++m) {
                    const int r = row0 + ai * 128 + m * 16;
                    *(f32x4*)(DT + (size_t)r * 32 + 8 * fq) = acc[ai][0][m][0];
                    *(f32x4*)(DT + (size_t)r * 32 + 8 * fq + 4) = acc[ai][0][m][1];
                }
        }
    }
};
struct EpiVT {
    static constexpr bool PERM = true, AFTER_DRAIN = false;
    char* ws;
    DI void operator()(const pg8::f32x4 (&acc)[2][2][4][2], const pg8::Unit& u, int wr, int wc, int fr, int fq) const {
        u16* VT = (u16*)(ws + OFF_VT);
#pragma unroll
        for (int ai = 0; ai < 2; ++ai)
#pragma unroll
            for (int m = 0; m < 4; ++m) {
                const int eg = u.pm * 256 + ai * 128 + wr * 64 + m * 16 + fr, head = eg >> 7, e = eg & 127;
#pragma unroll
                for (int bj = 0; bj < 2; ++bj) {
                    const int tok = u.pn * 256 + bj * 128 + wc * 32 + 8 * fq, b = tok >> 13, t = tok & 8191;
                    const pg8::f32x4 v0 = acc[ai][bj][m][0], v1 = acc[ai][bj][m][1];
                    u32x4 wv4; wv4.x = pk2(v0[0], v0[1]); wv4.y = pk2(v0[2], v0[3]); wv4.z = pk2(v1[0], v1[1]); wv4.w = pk2(v1[2], v1[3]);
                    u16* vp = VT + ((size_t)((b * 8 + head) * 128 + (t >> 6))) * 8192 + e * 64 + (t & 48) + ((t >> 3) & 1) * 4;
                    u32x2 lo2, hi2; lo2.x = wv4.x; lo2.y = wv4.y; hi2.x = wv4.z; hi2.y = wv4.w;
                    __builtin_nontemporal_store(lo2, (u32x2*)vp); __builtin_nontemporal_store(hi2, (u32x2*)(vp + 8));
                }
            }
    }
};
struct EpiOut {
    static constexpr bool PERM = true, AFTER_DRAIN = false;
    u16* mix;
    DI void operator()(const pg8::f32x4 (&acc)[2][2][4][2], const pg8::Unit& u, int wr, int wc, int fr, int fq) const {
#pragma unroll
        for (int ai = 0; ai < 2; ++ai)
#pragma unroll
            for (int m = 0; m < 4; ++m) {
                const int r = u.pm * 256 + ai * 128 + wr * 64 + m * 16 + fr;
#pragma unroll
                for (int bj = 0; bj < 2; ++bj) {
                    const pg8::f32x4 v0 = acc[ai][bj][m][0], v1 = acc[ai][bj][m][1];
                    u32x4 wv4; wv4.x = pk2(v0[0], v0[1]); wv4.y = pk2(v0[2], v0[3]); wv4.z = pk2(v1[0], v1[1]); wv4.w = pk2(v1[2], v1[3]);
                    *(u32x4*)(mix + (size_t)r * 1024 + u.pn * 256 + bj * 128 + wc * 32 + 8 * fq) = wv4;
                }
            }
    }
};

DI void phase_gemm1(const Params& p, char* lds, int wv) {
    const u16* HB = (const u16*)p.out;
    const u16* WIT = HB + (size_t)M_TOK * 1024;
    PG8_LAS unsigned char* l3 = (PG8_LAS unsigned char*)lds;
    pg8::StaticOrder S;
    {
        const pg8::Gemm g{HB, HB, WIT, M_TOK, 5888, 1024, 1024, 1 << 20};
        S.init(M_TOK, 5888, gridDim.x, blockIdx.x);
        pg8::gemm_phase<EpiProj, pg8::StaticOrder, true, true>(l3, g, S, EpiProj{p.ws}, wv);
    }
    {
        const pg8::Gemm g{WIT + (size_t)5888 * 1024, WIT + (size_t)5888 * 1024, HB, 1024, M_TOK, 1024, 1024, 1 << 20};
        S.init(1024, M_TOK, gridDim.x, blockIdx.x);
        pg8::gemm_phase<EpiVT, pg8::StaticOrder, true, true>(l3, g, S, EpiVT{p.ws}, wv);
    }
}

DI unsigned pair_pack(float x0, float x1, int odd) {
    const float send = odd ? x0 : x1;
    const float recv = __builtin_bit_cast(float, __builtin_amdgcn_mov_dpp(__builtin_bit_cast(int, send), 0xB1, 0xF, 0xF, true));
    return odd ? pk2(recv, x1) : pk2(x0, recv);
}

DI void ssdA_item(const Params& p, int item, char* lds, int wv) {
    const int tid = otid(wv), lane = tid & 63, w = __builtin_amdgcn_readfirstlane(tid >> 6), l31 = lane & 31, hh = lane >> 5;
    const int g = item & 1, c = (item >> 1) & 63, b = item >> 7;
    const int t0 = b * 8192 + c * 128;
    char* sB = lds; char* sC = lds + 34816; char* sBT = lds + 69632;
    float* tab = (float*)(lds + 104448);
    float* t_af = tab; float* t_ab = tab + 1024; float* t_df = tab + 2048; float* t_db = tab + 3072;
    float* part = (float*)(lds + 120832);
    const u16* XBC = (const u16*)(p.ws + OFF_XBC);
    const float* DT = (const float*)(p.ws + OFF_DT);
    float* EA = (float*)(p.ws + OFF_EA);
    float* DEC = (float*)(p.ws + OFF_DEC);
    u16* YL = (u16*)(p.ws + OFF_YL);
    u16* ST = (u16*)p.out;
    if (w >= 4) __builtin_amdgcn_s_setprio(1);
    {
        const int j = w, hd = g * 8 + j;
#pragma unroll
        for (int dir = 0; dir < 2; ++dir) {
            const float A = -expf(dir ? p.A_log_b[hd] : p.A_log_f[hd]) * LOG2E;
            const float bias = dir ? p.dt_bias_b[hd] : p.dt_bias_f[hd];
            const int col = dir * 16 + hd;
            const float d0 = softplusf(DT[(size_t)(t0 + lane) * 32 + col] + bias);
            const float d1 = softplusf(DT[(size_t)(t0 + lane + 64) * 32 + col] + bias);
            const float a0 = d0 * A, a1 = d1 * A;
            float s0 = a0, s1 = a1;
#pragma unroll
            for (int o = 1; o < 64; o <<= 1) {
                const float u0 = __shfl_up(s0, o), u1 = __shfl_up(s1, o);
                if (lane >= o) { s0 += u0; s1 += u1; }
            }
            const float tot0 = __shfl(s0, 63);
            s1 += tot0;
            const float total = __shfl(s1, 63);
            float e0, e1;
            if (dir == 0) { e0 = s0; e1 = s1; t_af[j * 128 + lane] = e0; t_af[j * 128 + lane + 64] = e1; t_df[j * 128 + lane] = d0; t_df[j * 128 + lane + 64] = d1; }
            else { e0 = total - (s0 - a0); e1 = total - (s1 - a1); t_ab[j * 128 + lane] = e0; t_ab[j * 128 + lane + 64] = e1; t_db[j * 128 + lane] = d0; t_db[j * 128 + lane + 64] = d1; }
            EA[(size_t)(t0 + lane) * 32 + col] = exp2f(e0);
            EA[(size_t)(t0 + lane + 64) * 32 + col] = exp2f(e1);
            if (lane == 0) DEC[((b * 16 + hd) * 2 + dir) * 64 + c] = exp2f(total);
        }
    }
    {
        const int cp = tid & 127, tg = tid >> 7;
        const bool isC = cp >= 64; const int n = 2 * (cp & 63);
        const int col = (isC ? 1280 : 1024) + g * 128 + n;
        float w0[5], w1[5];
#pragma unroll
        for (int k = 0; k < 5; ++k) { w0[k] = p.conv_w[k * 1536 + col]; w1[k] = p.conv_w[k * 1536 + col + 1]; }
        const float b0 = p.conv_b[col], b1 = p.conv_b[col + 1];
#pragma unroll 1
        for (int half = 0; half < 2; ++half) {
            const int lbase = tg * 32 + half * 16;
            unsigned win[20];
#pragma unroll
            for (int i = 0; i < 20; ++i) {
                const int lt = lbase - 2 + i, ts = c * 128 + lt;
                win[i] = (ts >= 0 && ts < 8192) ? *(const unsigned*)(XBC + (size_t)(t0 + lt) * 1536 + col) : 0u;
            }
#pragma unroll
            for (int i = 0; i < 16; ++i) {
                const int l = lbase + i;
                float v0 = b0, v1 = b1;
#pragma unroll
                for (int k = 0; k < 5; ++k) { v0 += w0[k] * bflo(win[i + k]); v1 += w1[k] * bfhi(win[i + k]); }
                v0 = siluf(v0); v1 = siluf(v1);
                const unsigned u = pk2(v0, v1);
                if (!isC) {
                    *(unsigned*)(sB + l * 272 + n * 2) = u;
                    *(u16*)(sBT + n * 272 + l * 2) = (u16)(u & 0xffffu);
                    *(u16*)(sBT + (n + 1) * 272 + l * 2) = (u16)(u >> 16);
                } else *(unsigned*)(sC + l * 272 + n * 2) = u;
            }
        }
    }
    __syncthreads();
    const int lb = w & 3, sh = w >> 2;
    f32x16 cbt[2];
#pragma unroll
    for (int sbl = 0; sbl < 2; ++sbl) {
        cbt[sbl] = zero16();
#pragma unroll
        for (int ks = 0; ks < 8; ++ks) {
            const bf16x8 a = *(const bf16x8*)(sB + ((sh * 2 + sbl) * 32 + l31) * 272 + (ks * 16 + hh * 8) * 2);
            const bf16x8 bq = *(const bf16x8*)(sC + (lb * 32 + l31) * 272 + (ks * 16 + hh * 8) * 2);
            cbt[sbl] = MFMA(a, bq, cbt[sbl]);
        }
    }
    __syncthreads();
    char* sX = lds; char* sXF = lds + 17408; char* sXB = lds + 34816;
    unsigned winn[12];
    {
        const int cp = tid & 31, tg = tid >> 5, lbase = tg * 8, col = (g * 8) * 64 + 2 * cp;
#pragma unroll
        for (int i = 0; i < 12; ++i) {
            const int lt = lbase - 2 + i, ts = c * 128 + lt;
            winn[i] = (ts >= 0 && ts < 8192) ? *(const unsigned*)(XBC + (size_t)(t0 + lt) * 1536 + col) : 0u;
        }
    }
#pragma unroll 1
    for (int j = 0; j < 8; ++j) {
        const int hd = g * 8 + j;
        {
            const int cp = tid & 31, tg = tid >> 5;
            const int col = hd * 64 + 2 * cp;
            float w0[5], w1[5];
#pragma unroll
            for (int k = 0; k < 5; ++k) { w0[k] = p.conv_w[k * 1536 + col]; w1[k] = p.conv_w[k * 1536 + col + 1]; }
            const float b0 = p.conv_b[col], b1 = p.conv_b[col + 1];
            const int lbase = tg * 8;
            unsigned win[12];
#pragma unroll
            for (int i = 0; i < 12; ++i) win[i] = winn[i];
            if (j < 7) {
#pragma unroll
                for (int i = 0; i < 12; ++i) {
                    const int lt = lbase - 2 + i, ts = c * 128 + lt;
                    winn[i] = (ts >= 0 && ts < 8192) ? *(const unsigned*)(XBC + (size_t)(t0 + lt) * 1536 + col + 64) : 0u;
                }
            }
            const float afend = t_af[j * 128 + 127], ab0 = t_ab[j * 128];
            float o0[8], o1[8];
#pragma unroll
            for (int i = 0; i < 8; ++i) {
                float v0 = b0, v1 = b1;
#pragma unroll
                for (int k = 0; k < 5; ++k) { v0 += w0[k] * bflo(win[i + k]); v1 += w1[k] * bfhi(win[i + k]); }
                o0[i] = siluf(v0); o1[i] = siluf(v1);
            }
            const int p0 = 2 * cp;
            *(bf16x8*)(sX + p0 * 272 + lbase * 2) = pack8(o0[0], o0[1], o0[2], o0[3], o0[4], o0[5], o0[6], o0[7]);
            *(bf16x8*)(sX + (p0 + 1) * 272 + lbase * 2) = pack8(o1[0], o1[1], o1[2], o1[3], o1[4], o1[5], o1[6], o1[7]);
            float wv[8];
#pragma unroll
            for (int i = 0; i < 8; ++i) wv[i] = t_df[j * 128 + lbase + i] * __builtin_amdgcn_exp2f(afend - t_af[j * 128 + lbase + i]);
            *(bf16x8*)(sXF + p0 * 272 + lbase * 2) = pack8(o0[0] * wv[0], o0[1] * wv[1], o0[2] * wv[2], o0[3] * wv[3], o0[4] * wv[4], o0[5] * wv[5], o0[6] * wv[6], o0[7] * wv[7]);
            *(bf16x8*)(sXF + (p0 + 1) * 272 + lbase * 2) = pack8(o1[0] * wv[0], o1[1] * wv[1], o1[2] * wv[2], o1[3] * wv[3], o1[4] * wv[4], o1[5] * wv[5], o1[6] * wv[6], o1[7] * wv[7]);
#pragma unroll
            for (int i = 0; i < 8; ++i) wv[i] = t_db[j * 128 + lbase + i] * __builtin_amdgcn_exp2f(ab0 - t_ab[j * 128 + lbase + i]);
            *(bf16x8*)(sXB + p0 * 272 + lbase * 2) = pack8(o0[0] * wv[0], o0[1] * wv[1], o0[2] * wv[2], o0[3] * wv[3], o0[4] * wv[4], o0[5] * wv[5], o0[6] * wv[6], o0[7] * wv[7]);
            *(bf16x8*)(sXB + (p0 + 1) * 272 + lbase * 2) = pack8(o1[0] * wv[0], o1[1] * wv[1], o1[2] * wv[2], o1[3] * wv[3], o1[4] * wv[4], o1[5] * wv[5], o1[6] * wv[6], o1[7] * wv[7]);
        }
        __syncthreads();
        f32x16 y[2]; y[0] = zero16(); y[1] = zero16();
        {
            const int l = lb * 32 + l31;
            const float afl = t_af[j * 128 + l], abl = t_ab[j * 128 + l];
            const float Dh = p.D[hd];
#pragma unroll
            for (int sbl = 0; sbl < 2; ++sbl) {
                const int sb = sh * 2 + sbl;
                float dloc = (float)((lb - sb) * 32 + l31 - 4 * hh);
                asm volatile("" : "+v"(dloc));
                float m[16];
#pragma unroll
                for (int grp = 0; grp < 4; ++grp) {
                    const int sbase = sb * 32 + 8 * grp + 4 * hh;
                    const f32x4 afs = *(const f32x4*)(t_af + j * 128 + sbase);
                    const f32x4 dfs = *(const f32x4*)(t_df + j * 128 + sbase);
                    const f32x4 abs_ = *(const f32x4*)(t_ab + j * 128 + sbase);
                    const f32x4 dbs = *(const f32x4*)(t_db + j * 128 + sbase);
#pragma unroll
                    for (int q = 0; q < 4; ++q) {
                        const float dq = dloc - (float)(8 * grp + q);
                        const float fm = __builtin_amdgcn_fmed3f(dq + 1.f, 0.f, 1.f), bm = __builtin_amdgcn_fmed3f(1.f - dq, 0.f, 1.f);
                        const float f = fm * __builtin_amdgcn_exp2f(fminf(afl - afs[q], 0.f)) * dfs[q];
                        const float bw = bm * __builtin_amdgcn_exp2f(fminf(abl - abs_[q], 0.f)) * dbs[q];
                        m[grp * 4 + q] = cbt[sbl][grp * 4 + q] * (f + bw) + fm * bm * Dh;
                    }
                    __builtin_amdgcn_sched_barrier(0);
                }
#pragma unroll
                for (int s2 = 0; s2 < 2; ++s2) {
                    const bf16x8 afrag = pack8(m[8 * s2], m[8 * s2 + 1], m[8 * s2 + 2], m[8 * s2 + 3], m[8 * s2 + 4], m[8 * s2 + 5], m[8 * s2 + 6], m[8 * s2 + 7]);
#pragma unroll
                    for (int pb = 0; pb < 2; ++pb) {
                        const char* xp = sX + (pb * 32 + l31) * 272 + (sb * 32 + 16 * s2 + 4 * hh) * 2;
                        const bf16x4 lo = *(const bf16x4*)xp, hi = *(const bf16x4*)(xp + 16);
                        const bf16x8 bfrag = __builtin_shufflevector(lo, hi, 0, 1, 2, 3, 4, 5, 6, 7);
                        y[pb] = MFMA(afrag, bfrag, y[pb]);
                    }
                }
                __builtin_amdgcn_sched_barrier(0);
            }
            if (sh == 1) {
#pragma unroll
                for (int pb = 0; pb < 2; ++pb)
#pragma unroll
                    for (int i = 0; i < 16; ++i) part[(lb * 32 + pb * 16 + i) * 64 + lane] = y[pb][i];
            }
        }
        {
            const int dir = w & 1, nblk = w >> 1;
            const char* xa = dir ? sXB : sXF;
            f32x16 st[2]; st[0] = zero16(); st[1] = zero16();
#pragma unroll
            for (int ks = 0; ks < 8; ++ks) {
                const bf16x8 bq = *(const bf16x8*)(sBT + (nblk * 32 + l31) * 272 + (ks * 16 + hh * 8) * 2);
#pragma unroll
                for (int pb2 = 0; pb2 < 2; ++pb2) {
                    const bf16x8 a = *(const bf16x8*)(xa + (pb2 * 32 + l31) * 272 + (ks * 16 + hh * 8) * 2);
                    st[pb2] = MFMA(a, bq, st[pb2]);
                }
            }
            u16* dst = ST + ((((size_t)(b * 16 + hd) * 2 + dir) * 64 + c) * 8192);
            const int odd = lane & 1;
#pragma unroll
            for (int pb2 = 0; pb2 < 2; ++pb2)
#pragma unroll
                for (int i = 0; i < 16; i += 2)
                    __builtin_nontemporal_store(pair_pack(st[pb2][i], st[pb2][i + 1], odd), (unsigned*)(dst + (pb2 * 32 + crow(i + odd, hh)) * 128 + nblk * 32 + l31 - odd));
        }
        __syncthreads();
        if (sh == 0) {
#pragma unroll
            for (int pb = 0; pb < 2; ++pb)
                {
                    float v[16];
#pragma unroll
                    for (int i = 0; i < 16; ++i) v[i] = y[pb][i] + part[(lb * 32 + pb * 16 + i) * 64 + lane];
                    u16* yp = YL + (((((size_t)item * 8 + j) * 4 + lb) * 2 + pb) * 64 + lane) * 16;
                    *(bf16x8*)yp = pack8(v[0], v[1], v[2], v[3], v[4], v[5], v[6], v[7]);
                    *(bf16x8*)(yp + 8) = pack8(v[8], v[9], v[10], v[11], v[12], v[13], v[14], v[15]);
                }
        }
    }
    __builtin_amdgcn_s_setprio(0);
}

DI void phase_scan(const Params& p, int wv) {
    u16* ST = (u16*)p.out;
    const float* DEC = (const float*)(p.ws + OFF_DEC);
    const int nthreads = gridDim.x * 512;
    for (int e = blockIdx.x * 512 + otid(wv); e < 64 * 2048; e += nthreads) {
        const int combo = e >> 11, quad = e & 2047;
        u16* base = ST + (size_t)combo * (64 * 8192) + quad * 4;
        const float* dec = DEC + combo * 64;
        const bool bwd = combo & 1;
        float r0 = 0.f, r1 = 0.f, r2 = 0.f, r3 = 0.f;
        const int c0 = bwd ? 63 : 0, cs = bwd ? -1 : 1;
#pragma unroll 1
        for (int bt = 0; bt < 4; ++bt) {
            u32x2 v[16]; float d[16];
#pragma unroll
            for (int i = 0; i < 16; ++i) { const int ch = c0 + cs * (bt * 16 + i); v[i] = *(const u32x2*)(base + (size_t)ch * 8192); d[i] = dec[ch]; }
#pragma unroll
            for (int i = 0; i < 16; ++i) {
                u32x2 o; o.x = pk2(r0, r1); o.y = pk2(r2, r3);
                r0 = d[i] * r0 + bflo(v[i].x); r1 = d[i] * r1 + bfhi(v[i].x); r2 = d[i] * r2 + bflo(v[i].y); r3 = d[i] * r3 + bfhi(v[i].y);
                v[i] = o;
            }
#pragma unroll
            for (int i = 0; i < 16; ++i) { const int ch = c0 + cs * (bt * 16 + i); *(u32x2*)(base + (size_t)ch * 8192) = v[i]; }
        }
    }
    {
        const int tid = otid(wv), lane = tid & 63, w = __builtin_amdgcn_readfirstlane(tid >> 6);
        const u16* Kg = (const u16*)(p.ws + OFF_K);
        unsigned* KN = (unsigned*)(p.ws + OFF_KN);
        for (int cb = blockIdx.x; cb < 256; cb += gridDim.x) {
            float mx = 0.f;
#pragma unroll 4
            for (int i = 0; i < 8; ++i) {
                const int ch = cb * 64 + w * 8 + i;
                const u32x4 a = *(const u32x4*)(Kg + (size_t)ch * 1024 + lane * 16);
                const u32x4 c = *(const u32x4*)(Kg + (size_t)ch * 1024 + lane * 16 + 8);
                float ss = 0.f;
#pragma unroll
                for (int e = 0; e < 4; ++e) { const float x0 = bflo(a[e]), x1 = bfhi(a[e]), x2 = bflo(c[e]), x3 = bfhi(c[e]); ss += x0 * x0 + x1 * x1 + x2 * x2 + x3 * x3; }
                ss += __shfl_xor(ss, 1); ss += __shfl_xor(ss, 2);
                mx = fmaxf(mx, ss);
            }
#pragma unroll
            for (int o = 4; o < 64; o <<= 1) mx = fmaxf(mx, __shfl_xor(mx, o));
            if (lane == 0) atomicMax(&KN[cb >> 4], __float_as_uint(mx));
        }
    }
}

DI void ssdC_item(const Params& p, int item, char* lds, int wv) {
    const int tid = otid(wv), lane = tid & 63, w = __builtin_amdgcn_readfirstlane(tid >> 6), l31 = lane & 31, hh = lane >> 5;
    const int g = item & 1, c = (item >> 1) & 63, b = item >> 7;
    const int t0 = b * 8192 + c * 128;
    char* sC = lds;
    if (w >= 4) __builtin_amdgcn_s_setprio(1);
    float* ea = (float*)(lds + 34816);
    float* ssq = ea + 2048;
    float* rs = ssq + 1024;
    const u16* XBC = (const u16*)(p.ws + OFF_XBC);
    const float* EA = (const float*)(p.ws + OFF_EA);
    const u16* YL = (const u16*)(p.ws + OFF_YL);
    u16* Z = (u16*)(p.ws + OFF_Z);
    const u16* ST = (const u16*)p.out;
    for (int idx = tid; idx < 2048; idx += 512) {
        const int l = idx >> 4, cc = idx & 15, dir = cc >> 3, j = cc & 7;
        ea[(dir * 8 + j) * 128 + l] = EA[(size_t)(t0 + l) * 32 + dir * 16 + g * 8 + j];
    }
    {
        const int cp = tid & 63, tg = tid >> 6;
        const int n = 2 * cp, col = 1280 + g * 128 + n;
        float w0[5], w1[5];
#pragma unroll
        for (int k = 0; k < 5; ++k) { w0[k] = p.conv_w[k * 1536 + col]; w1[k] = p.conv_w[k * 1536 + col + 1]; }
        const float b0 = p.conv_b[col], b1 = p.conv_b[col + 1];
        const int lbase = tg * 16;
        unsigned win[20];
#pragma unroll
        for (int i = 0; i < 20; ++i) {
            const int lt = lbase - 2 + i, ts = c * 128 + lt;
            win[i] = (ts >= 0 && ts < 8192) ? *(const unsigned*)(XBC + (size_t)(t0 + lt) * 1536 + col) : 0u;
        }
#pragma unroll
        for (int i = 0; i < 16; ++i) {
            float v0 = b0, v1 = b1;
#pragma unroll
            for (int k = 0; k < 5; ++k) { v0 += w0[k] * bflo(win[i + k]); v1 += w1[k] * bfhi(win[i + k]); }
            *(unsigned*)(sC + (lbase + i) * 272 + n * 2) = pk2(siluf(v0), siluf(v1));
        }
    }
    __syncthreads();
    const int j = w, hd = g * 8 + j;
#pragma unroll 1
    for (int lh = 0; lh < 2; ++lh) {
        f32x16 y[2][2];
#pragma unroll
        for (int a = 0; a < 2; ++a) { y[a][0] = zero16(); y[a][1] = zero16(); }
#pragma unroll 1
        for (int dir = 0; dir < 2; ++dir) {
            const u16* prev = ST + ((((size_t)(b * 16 + hd) * 2 + dir) * 64 + c) * 8192);
            asm volatile("" ::: "memory");
            bf16x8 bfr[2][8];
#pragma unroll
            for (int pblk = 0; pblk < 2; ++pblk)
#pragma unroll
                for (int ks = 0; ks < 8; ++ks) bfr[pblk][ks] = *(const bf16x8*)(prev + (pblk * 32 + l31) * 128 + ks * 16 + hh * 8);
#pragma unroll
            for (int pblk = 0; pblk < 2; ++pblk) {
#pragma unroll
                for (int lb2 = 0; lb2 < 2; ++lb2) {
                    const int lbk = lh * 2 + lb2;
                    f32x16 acc = zero16();
#pragma unroll
                    for (int ks = 0; ks < 8; ++ks) {
                        const bf16x8 a = *(const bf16x8*)(sC + (lbk * 32 + l31) * 272 + (ks * 16 + hh * 8) * 2);
                        acc = MFMA(a, bfr[pblk][ks], acc);
                    }
#pragma unroll
                    for (int grp = 0; grp < 4; ++grp) {
                        const f32x4 e4 = *(const f32x4*)(ea + (dir * 8 + j) * 128 + lbk * 32 + 8 * grp + 4 * hh);
#pragma unroll
                        for (int q = 0; q < 4; ++q) y[lb2][pblk][grp * 4 + q] += e4[q] * acc[grp * 4 + q];
                    }
                }
            }
        }
        const int odd = lane & 1;
#pragma unroll
        for (int lb2 = 0; lb2 < 2; ++lb2) {
            u32x4 ylr[2][2];
#pragma unroll
            for (int pblk = 0; pblk < 2; ++pblk) {
                const u16* yp = YL + (((((size_t)item * 8 + j) * 4 + (lh * 2 + lb2)) * 2 + pblk) * 64 + lane) * 16;
                ylr[pblk][0] = *(const u32x4*)yp; ylr[pblk][1] = *(const u32x4*)(yp + 8);
            }
#pragma unroll
            for (int i = 0; i < 16; i += 2) {
                const int l0 = (lh * 2 + lb2) * 32 + crow(i, hh);
                float ss0 = 0.f, ss1 = 0.f;
#pragma unroll
                for (int pblk = 0; pblk < 2; ++pblk) {
                    const size_t idx = (size_t)(t0 + l0 + odd) * 1024 + hd * 64 + pblk * 32 + l31 - odd;
                    const unsigned lz = *(const unsigned*)(Z + idx);
                    const unsigned rz = (unsigned)__builtin_amdgcn_mov_dpp((int)lz, 0xB1, 0xF, 0xF, true);
                    const unsigned yw = ylr[pblk][i >> 3][(i >> 1) & 3];
                    const float yl0 = bflo(yw), yl1 = bfhi(yw);
                    const float z0 = odd ? bfhi(rz) : bflo(lz), z1 = odd ? bfhi(lz) : bflo(rz);
                    const float v0 = (y[lb2][pblk][i] + yl0) * siluf(z0), v1 = (y[lb2][pblk][i + 1] + yl1) * siluf(z1);
                    y[lb2][pblk][i] = v0; y[lb2][pblk][i + 1] = v1; ss0 += v0 * v0; ss1 += v1 * v1;
                }
#pragma unroll
                for (int o = 16; o > 0; o >>= 1) { ss0 += __shfl_xor(ss0, o); ss1 += __shfl_xor(ss1, o); }
                if (l31 == 0) { ssq[j * 128 + l0] = ss0; ssq[j * 128 + l0 + 1] = ss1; }
            }
            asm volatile("" ::: "memory");
        }
        __syncthreads();
        if (tid < 64) {
            const int l = lh * 64 + tid;
            float tot = 0.f;
#pragma unroll
            for (int jj = 0; jj < 8; ++jj) tot += ssq[jj * 128 + l];
            rs[l] = rsqrtf(tot * (1.f / 512.f) + 1e-5f);
        }
        __syncthreads();
#pragma unroll
        for (int pblk = 0; pblk < 2; ++pblk) {
            const float gain = p.ssm_norm_g[hd * 64 + pblk * 32 + l31];
#pragma unroll
            for (int lb2 = 0; lb2 < 2; ++lb2)
#pragma unroll
                for (int grp = 0; grp < 4; ++grp) {
                    const int lq = (lh * 2 + lb2) * 32 + 8 * grp + 4 * hh;
                    const f32x4 r4 = *(const f32x4*)(rs + lq);
#pragma unroll
                    for (int q = 0; q < 4; q += 2)
                        *(unsigned*)(Z + (size_t)(t0 + lq + q + odd) * 1024 + hd * 64 + pblk * 32 + l31 - odd) =
                            pair_pack(y[lb2][pblk][grp * 4 + q] * r4[q] * gain, y[lb2][pblk][grp * 4 + q + 1] * r4[q + 1] * gain, odd);
                }
        }
    }
    __syncthreads();
    __builtin_amdgcn_s_setprio(0);
}

DI void attn_item(const Params& p, int b, int h, int qb, float lam, char* lds, int wv) {
    const int tid = otid(wv), lane = tid & 63, w = __builtin_amdgcn_readfirstlane(tid >> 6), l31 = lane & 31, hh = lane >> 5;
    const int r = w & 1, qs = w >> 1;
    u16* Q = (u16*)(p.ws + OFF_Q);
    const u16* Kg = (const u16*)(p.ws + OFF_K);
    const u16* VT = (const u16*)(p.ws + OFF_VT);
    const u16* G = (const u16*)(p.ws + OFF_G);
    float* red = (float*)(lds + 131072);
    const int wq0 = qb * 128 + qs * 32;
    const int tq = wq0 + l31;
    const size_t row = (size_t)b * 8192 + tq;
    bf16x8 qf[4];
#pragma unroll
    for (int ks = 0; ks < 4; ++ks) qf[ks] = *(const bf16x8*)(Q + row * 1024 + h * 128 + r * 64 + ks * 16 + hh * 8);
    const float kn2 = __uint_as_float(((const unsigned*)(p.ws + OFF_KN))[b * 8 + h]);
    float mref;
    {
        float ss = 0.f, dg = 0.f;
#pragma unroll
        for (int ks = 0; ks < 4; ++ks) {
            const bf16x8 kd = *(const bf16x8*)(Kg + ((size_t)(b * 8 + h) * 8192 + tq) * 128 + r * 64 + ks * 16 + hh * 8);
#pragma unroll
            for (int e = 0; e < 8; ++e) { const float v = bf2f((u16)qf[ks][e]); ss += v * v; dg += v * bf2f((u16)kd[e]); }
        }
        ss += __shfl_xor(ss, 32); dg += __shfl_xor(dg, 32);
        mref = 0.5f * (sqrtf(ss * kn2) * 1.001f + dg);
#pragma unroll
        for (int o = 16; o > 0; o >>= 1) { ss = fmaxf(ss, __shfl_xor(ss, o)); dg = fminf(dg, __shfl_xor(dg, o)); }
        if (lane == 0) { red[w] = ss; red[8 + w] = dg; }
    }
    __syncthreads();
    float qn2 = red[0], dmin = red[8];
#pragma unroll
    for (int i = 1; i < 8; ++i) { qn2 = fmaxf(qn2, red[i]); dmin = fminf(dmin, red[8 + i]); }
    const float ms = __builtin_bit_cast(float, __builtin_amdgcn_readfirstlane(__builtin_bit_cast(int, exp2f(-(float)(h + 1)) * LOG2E)));
    const float Dw = fminf((1.001f * sqrtf(qn2 * kn2) - dmin + 40.f) / ms, 1e6f);
    const float q0f = (float)(qb * 128);
    int lo = (int)floorf((q0f - 63.f - Dw) * (1.f / 64.f)) + 1; lo = lo < 0 ? 0 : lo;
    int hi = (int)ceilf((q0f + 127.f + Dw) * (1.f / 64.f)) - 1; hi = hi > 127 ? 127 : hi;
    lo = __builtin_amdgcn_readfirstlane(lo); hi = __builtin_amdgcn_readfirstlane(hi);
    f32x16 O[4];
#pragma unroll
    for (int e = 0; e < 4; ++e) O[e] = zero16();
    float lsum = 0.f;
    const u16* kbase = Kg + (size_t)(b * 8 + h) * 8192 * 128;
    const u16* vbase = VT + (size_t)((b * 8 + h) * 128) * 8192;
    unsigned ksrc[2], vsrc[2];
#pragma unroll
    for (int j = 0; j < 2; ++j) {
        const int piece = w * 2 + j;
        const int key = piece * 4 + (lane >> 4), kpos = lane & 15;
        ksrc[j] = (unsigned)(key * 128 + ((kpos ^ (key & 15)) * 8));
        const int ev = piece * 8 + (lane >> 3), vpos = lane & 7;
        vsrc[j] = (unsigned)(ev * 64 + ((vpos ^ ((ev >> 1) & 7)) * 8));
    }
#define ADMA(kt, buf) do { \
    _Pragma("unroll") for (int j_ = 0; j_ < 2; ++j_) { \
        __builtin_amdgcn_global_load_lds((const unsigned*)(kbase + (size_t)(kt) * 8192 + ksrc[j_]), (LAS unsigned*)(lds + (buf) * 32768 + (w * 2 + j_) * 1024), 16, 0, 0); \
        __builtin_amdgcn_global_load_lds((const unsigned*)(vbase + (size_t)(kt) * 8192 + vsrc[j_]), (LAS unsigned*)(lds + (buf) * 32768 + 16384 + (w * 2 + j_) * 1024), 16, 0, 0); } } while (0)
#define SB __builtin_amdgcn_sched_barrier(0)
    const unsigned kx = (unsigned)(l31 * 256 + (l31 & 15) * 16);
    const unsigned vx = (unsigned)(l31 * 128 + ((l31 >> 1) & 7) * 16);
    f32x16 s[2];
    bf16x8 vf[4];
#define EXP8(KB, H8) do { _Pragma("unroll") for (int i_ = 0; i_ < 8; ++i_) { const float pv_ = __builtin_amdgcn_exp2f(s[KB][(H8) * 8 + i_]); s[KB][(H8) * 8 + i_] = pv_; psum += pv_; } } while (0)
#define PVG(G4) do { const int kb_ = (G4) >> 1, s2_ = (G4) & 1; \
        const bf16x8 pfrag = pack8(s[kb_][8 * s2_], s[kb_][8 * s2_ + 1], s[kb_][8 * s2_ + 2], s[kb_][8 * s2_ + 3], s[kb_][8 * s2_ + 4], s[kb_][8 * s2_ + 5], s[kb_][8 * s2_ + 6], s[kb_][8 * s2_ + 7]); \
        SB; \
        _Pragma("unroll") for (int e = 0; e < 4; ++e) O[e] = MFMA(vf[e], pfrag, O[e]); \
        SB; \
        if ((G4) < 3) { _Pragma("unroll") for (int e = 0; e < 4; ++e) vf[e] = *(const bf16x8*)(vsm + e * 4096 + (vx ^ (unsigned)((((G4) + 1) * 2 + hh) * 16))); } \
        } while (0)
#define TILE_BODY(KT, SLOT) do { \
        const char* ksm = lds + (SLOT) * 32768; const char* vsm = ksm + 16384; \
        const int k0 = (KT) * 64; \
        const float dl2 = (float)(k0 + 4 * hh - tq); \
        bf16x8 kf[2][4]; \
        _Pragma("unroll") for (int kb = 0; kb < 2; ++kb) \
        _Pragma("unroll") for (int ks = 0; ks < 4; ++ks) kf[kb][ks] = *(const bf16x8*)(ksm + kb * 8192 + (kx ^ (unsigned)((r * 8 + ks * 2 + hh) * 16))); \
        SB; \
        if (k0 + 63 < wq0 || k0 > wq0 + 31) { \
            const float sm = (k0 + 63 < wq0) ? ms : -ms; \
            const float tl = sm * dl2 - mref; \
            _Pragma("unroll") for (int kb = 0; kb < 2; ++kb) \
            _Pragma("unroll") for (int i = 0; i < 16; ++i) s[kb][i] = __builtin_fmaf(sm, (float)(kb * 32 + (i & 3) + 8 * (i >> 2)), tl); \
        } else { \
            _Pragma("unroll") for (int kb = 0; kb < 2; ++kb) \
            _Pragma("unroll") for (int i = 0; i < 16; ++i) s[kb][i] = __builtin_fmaf(-ms, fabsf(dl2 + (float)(kb * 32 + (i & 3) + 8 * (i >> 2))), -mref); \
        } \
        SB; \
        _Pragma("unroll") for (int kb = 0; kb < 2; ++kb) \
        _Pragma("unroll") for (int ks = 0; ks < 4; ++ks) s[kb] = MFMA(kf[kb][ks], qf[ks], s[kb]); \
        _Pragma("unroll") for (int e = 0; e < 4; ++e) vf[e] = *(const bf16x8*)(vsm + e * 4096 + (vx ^ (unsigned)(hh * 16))); \
        SB; \
        float psum = 0.f; \
        EXP8(0, 0); EXP8(0, 1); \
        SB; \
        PVG(0); SB; EXP8(1, 0); SB; \
        PVG(1); SB; EXP8(1, 1); SB; \
        PVG(2); SB; \
        PVG(3); SB; \
        lsum += psum; \
    } while (0)
    ADMA(lo, 0);
    if (lo < hi) ADMA(lo + 1, 1);
    asm volatile("s_waitcnt vmcnt(0)" ::: "memory");
    __builtin_amdgcn_s_barrier();
    asm volatile("" ::: "memory");
    if (w >= 4) __builtin_amdgcn_s_setprio(1);
    int sb0 = 0;
    for (int kt = lo; kt <= hi; kt += 2) {
        const int nb0 = sb0 ^ 2;
        if (kt + 2 <= hi) ADMA(kt + 2, nb0);
        if (kt + 3 <= hi) ADMA(kt + 3, nb0 + 1);
        SB;
        TILE_BODY(kt, sb0);
        if (kt + 1 <= hi) TILE_BODY(kt + 1, sb0 + 1);
        asm volatile("s_waitcnt vmcnt(0)" ::: "memory");
        __builtin_amdgcn_s_barrier();
        asm volatile("" ::: "memory");
        sb0 = nb0;
    }
#undef TILE_BODY
#undef EXP8
#undef PVG
    __builtin_amdgcn_s_setprio(0);
    __syncthreads();
#undef ADMA
#undef SB
    lsum += __shfl_xor(lsum, 32);
    const float inv = 1.f / lsum;
    float* X = (float*)lds;
    if (r == 1) {
        const float sc = *(volatile float*)(lds + 131072 + 128) * inv;
#pragma unroll
        for (int e = 0; e < 4; ++e)
#pragma unroll
            for (int i = 0; i < 16; ++i) X[(qs * 64 + e * 16 + i) * 64 + lane] = O[e][i] * sc;
    }
    __syncthreads();
    if (r == 0) {
        float ss = 0.f;
#pragma unroll
        for (int e = 0; e < 4; ++e)
#pragma unroll
            for (int i = 0; i < 16; ++i) { const float o = O[e][i] * inv - X[(qs * 64 + e * 16 + i) * 64 + lane]; O[e][i] = o; ss += o * o; }
        ss += __shfl_xor(ss, 32);
        const float rstd = rsqrtf(ss * (1.f / 128.f) + 1e-5f) * 0.8f;
#pragma unroll
        for (int e = 0; e < 4; ++e)
#pragma unroll
            for (int grp = 0; grp < 4; ++grp) {
                const int ee = e * 32 + 8 * grp + 4 * hh;
                const u32x2 gg = *(const u32x2*)(G + row * 1024 + h * 128 + ee);
                const f32x4 sg = *(const f32x4*)(p.subln_g + ee);
                const float o0 = O[e][grp * 4 + 0] * rstd * sg[0] * siluf(bflo(gg.x));
                const float o1 = O[e][grp * 4 + 1] * rstd * sg[1] * siluf(bfhi(gg.x));
                const float o2 = O[e][grp * 4 + 2] * rstd * sg[2] * siluf(bflo(gg.y));
                const float o3 = O[e][grp * 4 + 3] * rstd * sg[3] * siluf(bfhi(gg.y));
                u32x2 ov; ov.x = pk2(o0, o1); ov.y = pk2(o2, o3);
                *(u32x2*)(Q + row * 1024 + h * 128 + ee) = ov;
            }
    }
    __syncthreads();
}

DI void phase_attn(const Params& p, char* lds, int wv) {
    const int tid = otid(wv), lane = tid & 63;
    const float d1 = wsum(p.lq1[lane] * p.lk1[lane]);
    const float d2 = wsum(p.lq2[lane] * p.lk2[lane]);
    if (tid == 0) *(volatile float*)(lds + 131072 + 128) = expf(d1) - expf(d2) + 0.2f;
    const float lam = 0.f;
    unsigned* ctr = (unsigned*)(p.ws + OFF_CTR);
    volatile int* s_item = (volatile int*)(lds + 131072 + 64);
    for (;;) {
        if (tid == 0) *s_item = (int)atomicAdd(ctr, 1u);
        __syncthreads();
        const int it = *s_item;
        if (it >= 1024) break;
        const int h = 7 - (it >> 7), b = (it >> 6) & 1, qb = it & 63;
        attn_item(p, b, h, qb, lam, lds, wv);
    }
}

DI void phase_gemm2(const Params& p, char* lds, int wv) {
    const pg8::Gemm g{(const u16*)(p.ws + OFF_Z), (const u16*)(p.ws + OFF_Q), (const u16*)(p.ws + OFF_WOT), M_TOK, 1024, 2048, 1024, 16};
    pg8::StaticOrder S; S.init(M_TOK, 1024, gridDim.x, blockIdx.x);
    pg8::gemm_phase<EpiOut, pg8::StaticOrder, true, true>((PG8_LAS unsigned char*)lds, g, S, EpiOut{(u16*)(p.ws + OFF_YL)}, wv);
}

DI void phase_ln_out(const Params& p, int wv) {
    const int tid = otid(wv), lane = tid & 63, w = __builtin_amdgcn_readfirstlane(tid >> 6);
    const int nwaves = gridDim.x * 8;
    f32x4 ge[4], be[4], g2[4], b2[4];
#pragma unroll
    for (int j = 0; j < 4; ++j) {
        ge[j] = *(const f32x4*)(p.ln_emb_g + j * 256 + lane * 4); be[j] = *(const f32x4*)(p.ln_emb_b + j * 256 + lane * 4);
        g2[j] = *(const f32x4*)(p.ln_g + j * 256 + lane * 4); b2[j] = *(const f32x4*)(p.ln_b + j * 256 + lane * 4);
    }
    int row = blockIdx.x * 8 + w;
    f32x4 xv[4]; u32x2 mv[4];
    const u16* MIX = (const u16*)(p.ws + OFF_YL);
    if (row < M_TOK) {
#pragma unroll
        for (int j = 0; j < 4; ++j) { xv[j] = __builtin_nontemporal_load((const f32x4*)(p.x + (size_t)row * 1024 + j * 256 + lane * 4)); mv[j] = __builtin_nontemporal_load((const u32x2*)(MIX + (size_t)row * 1024 + j * 256 + lane * 4)); }
    }
    for (; row < M_TOK; row += nwaves) {
        f32x4 xc[4], mc[4];
#pragma unroll
        for (int j = 0; j < 4; ++j) { xc[j] = xv[j]; mc[j][0] = bflo(mv[j].x); mc[j][1] = bfhi(mv[j].x); mc[j][2] = bflo(mv[j].y); mc[j][3] = bfhi(mv[j].y); }
        const int nrow = row + nwaves;
        if (nrow < M_TOK) {
#pragma unroll
            for (int j = 0; j < 4; ++j) { xv[j] = __builtin_nontemporal_load((const f32x4*)(p.x + (size_t)nrow * 1024 + j * 256 + lane * 4)); mv[j] = __builtin_nontemporal_load((const u32x2*)(MIX + (size_t)nrow * 1024 + j * 256 + lane * 4)); }
        }
        float s = 0.f;
#pragma unroll
        for (int j = 0; j < 4; ++j) s += xc[j][0] + xc[j][1] + xc[j][2] + xc[j][3];
        s = wsum(s);
        const float mean = s * (1.f / 1024.f);
        float q = 0.f;
#pragma unroll
        for (int j = 0; j < 4; ++j)
#pragma unroll
            for (int e = 0; e < 4; ++e) { const float d = xc[j][e] - mean; q += d * d; }
        q = wsum(q);
        const float rstd = rsqrtf(q * (1.f / 1024.f) + 1e-5f);
        float s2 = 0.f;
#pragma unroll
        for (int j = 0; j < 4; ++j)
#pragma unroll
            for (int e = 0; e < 4; ++e) { const float v = ALPHA_DN * ((xc[j][e] - mean) * rstd * ge[j][e] + be[j][e]) + mc[j][e]; mc[j][e] = v; s2 += v; }
        s2 = wsum(s2);
        const float mean2 = s2 * (1.f / 1024.f);
        float q2 = 0.f;
#pragma unroll
        for (int j = 0; j < 4; ++j)
#pragma unroll
            for (int e = 0; e < 4; ++e) { const float d = mc[j][e] - mean2; q2 += d * d; }
        q2 = wsum(q2);
        const float rstd2 = rsqrtf(q2 * (1.f / 1024.f) + 1e-5f);
#pragma unroll
        for (int j = 0; j < 4; ++j) {
            f32x4 h;
#pragma unroll
            for (int e = 0; e < 4; ++e) h[e] = (mc[j][e] - mean2) * rstd2 * g2[j][e] + b2[j][e];
            __builtin_nontemporal_store(h, (f32x4*)(p.out + (size_t)row * 1024 + j * 256 + lane * 4));
        }
    }
}

__global__ void __launch_bounds__(512) hybrid_fwd(Params p) {
    extern __shared__ __attribute__((aligned(16))) char lds[];
    cg::grid_group grid = cg::this_grid();
    const int wv = __builtin_amdgcn_readfirstlane((int)(threadIdx.x >> 6));
#define GBAR() do { XcdBarrier b_; b_.bar = (unsigned*)(p.ws + OFF_BAR); b_.x = xb_xcc_id(); b_.st = (volatile LAS unsigned*)(lds + LDS_BYTES - 16); xcd_barrier(b_, otid(wv) == 0); } while (0)
    if (threadIdx.x == 0) { volatile LAS unsigned* xst = (volatile LAS unsigned*)(lds + LDS_BYTES - 16); xst[0] = 0u; xst[1] = 0u; }
    phase_prep(p, lds, wv);
    grid.sync();
    (void)xcd_barrier_post((unsigned*)(p.ws + OFF_BAR), (volatile LAS unsigned*)(lds + LDS_BYTES - 16), otid(wv) == 0);
    phase_gemm1(p, lds, wv);
    GBAR();
    for (int it = blockIdx.x; it < 256; it += gridDim.x) ssdA_item(p, it, lds, wv);
    GBAR();
    phase_scan(p, wv);
    GBAR();
    for (int it = blockIdx.x; it < 256; it += gridDim.x) ssdC_item(p, it, lds, wv);
    phase_attn(p, lds, wv);
    GBAR();
    phase_gemm2(p, lds, wv);
    GBAR();
    phase_ln_out(p, wv);
#undef GBAR
}

extern "C" void kernel_launch(void* const* d_in, const int* in_sizes, int n_in, void* d_out, int out_size, void* d_ws, size_t ws_size,
                              hipStream_t stream) {
    static int grid_blocks = 0;
    if (!grid_blocks) {
        int dev = 0, cus = 0, per_cu = 0;
        hipGetDevice(&dev);
        hipDeviceGetAttribute(&cus, hipDeviceAttributeMultiprocessorCount, dev);
        hipFuncSetAttribute((const void*)hybrid_fwd, hipFuncAttributeMaxDynamicSharedMemorySize, LDS_BYTES);
        hipOccupancyMaxActiveBlocksPerMultiprocessor(&per_cu, hybrid_fwd, 512, LDS_BYTES);
        if (per_cu > 1) per_cu = 1;
        grid_blocks = cus * per_cu;
        if (grid_blocks <= 0) grid_blocks = 256;
    }
    if (ws_size < WS_NEED) { fprintf(stderr, "workspace too small: %zu < %zu\n", ws_size, (size_t)WS_NEED); return; }
    Params p{};
    const float** f = (const float**)&p;
    for (int i = 0; i < 20; ++i) f[i] = (const float*)d_in[i];
    p.out = (float*)d_out;
    p.ws = (char*)d_ws;
    void* args[] = {&p};
    hipError_t e = hipLaunchCooperativeKernel((const void*)hybrid_fwd, dim3(grid_blocks), dim3(512), args, LDS_BYTES, stream);
    if (e != hipSuccess) fprintf(stderr, "cooperative launch failed: %s (grid %d)\n", hipGetErrorString(e), grid_blocks);
}
```
